# Optimizing an MI355X kernel written in HIP

```python
import math
import jax, jax.numpy as jnp
from jax import lax
import numpy as np

D_MODEL = 1024
BATCH = 16
SEQ = 256
DEPTH = 4
DEC_BATCH = 8
DEC_SEQ = 4096
PAST_LEN = 256

GRID_W = 64
MIX_W = D_MODEL
N_MIXERS = 4
GROUP_W = MIX_W // N_MIXERS
SSM_CH = 16
SSM_GROUPS = GROUP_W // SSM_CH
SSM_STATE = 64
FNET_HEADS = 4
FNET_CH = GROUP_W // FNET_HEADS
POOL_WINDOWS = (2, 4, 8, 16)
POOL_CH = GROUP_W // len(POOL_WINDOWS)
SGU_HEADS = 4
SGU_CH = GROUP_W // SGU_HEADS
SGU_CHUNK = 128
D_FF = 2816
IN_COLS = 5 * GROUP_W
N_MOD = 9
ALPHA = (2 * DEPTH) ** 0.25
BETA = (8 * DEPTH) ** -0.25
LN_EPS = 1e-5

kernel_name = "hybrid_s5_fnet_pool_sgu_diffusion_step"


def layer_norm(x, g, b):
    x32 = x.astype(jnp.float32)
    mu = jnp.mean(x32, -1, keepdims=True)
    var = jnp.mean(jnp.square(x32 - mu), -1, keepdims=True)
    y = (x32 - mu) * lax.rsqrt(var + LN_EPS) * g.astype(jnp.float32) + b.astype(jnp.float32)
    return y.astype(x.dtype)


def swiglu(h, w_in, w_out):
    a, g = jnp.split(h @ w_in, 2, axis=-1)
    return (jax.nn.silu(g) * a) @ w_out


def sincos_2d(n_tokens):
    rows = n_tokens // GRID_W
    quarter = D_MODEL // 4
    omega = 1.0 / (10000.0 ** (jnp.arange(quarter, dtype=jnp.float32) / quarter))
    ang_r = jnp.arange(rows, dtype=jnp.float32)[:, None] * omega
    ang_c = jnp.arange(GRID_W, dtype=jnp.float32)[:, None] * omega
    emb_r = jnp.concatenate([jnp.sin(ang_r), jnp.cos(ang_r)], -1)
    emb_c = jnp.concatenate([jnp.sin(ang_c), jnp.cos(ang_c)], -1)
    half = D_MODEL // 2
    pos = jnp.concatenate([jnp.broadcast_to(emb_r[:, None], (rows, GRID_W, half)),
                           jnp.broadcast_to(emb_c[None], (rows, GRID_W, half))], -1)
    return pos.reshape(rows * GRID_W, D_MODEL)


def _ssm_combine(e1, e2):
    a1, b1 = e1
    a2, b2 = e2
    return a1 * a2, a2 * b1 + b2


def s5_mixer(u, lam_re, lam_im, log_dt, b_re, b_im, c_re, c_im, d_skip, glu_w, glu_b, h0_re, h0_im):
    f32 = jnp.float32
    nb, n, _ = u.shape
    u32 = u.astype(f32)
    ug = u32.reshape(nb, n, SSM_GROUPS, SSM_CH).astype(jnp.complex64)
    y = u32 * d_skip.astype(f32)
    fin_re, fin_im = [], []
    for dirn in range(2):
        lam = lax.complex(lam_re[dirn].astype(f32), lam_im[dirn].astype(f32))
        dt = jnp.exp(log_dt[dirn].astype(f32))[:, None]
        a_bar = jnp.exp(lam * dt)
        b_mat = lax.complex(b_re[dirn].astype(f32), b_im[dirn].astype(f32))
        b_bar = ((a_bar - 1.0) / lam)[..., None] * b_mat
        bu = jnp.einsum("blgh,gph->blgp", ug, b_bar)
        h0 = lax.complex(h0_re[:, dirn].astype(f32), h0_im[:, dirn].astype(f32))
        rev = dirn == 1
        first = n - 1 if rev else 0
        bu = bu.at[:, first].add(a_bar * h0)
        _, hs = lax.associative_scan(_ssm_combine, (jnp.broadcast_to(a_bar, bu.shape), bu),
                                     axis=1, reverse=rev)
        c_mat = lax.complex(c_re[dirn].astype(f32), c_im[dirn].astype(f32))
        y = y + jnp.einsum("blgp,ghp->blgh", hs, c_mat).real.reshape(nb, n, GROUP_W)
        fin = hs[:, 0] if rev else hs[:, -1]
        fin_re.append(jnp.real(fin))
        fin_im.append(jnp.imag(fin))
    y = jax.nn.gelu(y)
    y = y * jax.nn.sigmoid(y @ glu_w.astype(f32) + glu_b.astype(f32))
    return y, jnp.stack(fin_re, 1), jnp.stack(fin_im, 1)


def fnet_mixer(z, fnet_w):
    nb, n, _ = z.shape
    zh = z.astype(jnp.float32).reshape(nb, n, FNET_HEADS, FNET_CH)
    f = jnp.fft.fft2(zh, axes=(1, 3), norm="ortho").real
    return jnp.einsum("blgc,gcd->blgd", f, fnet_w.astype(jnp.float32)).reshape(nb, n, GROUP_W)


def pool_mixer(z, pool_w, pool_scale):
    f32 = jnp.float32
    nb, n, _ = z.shape
    ng = len(POOL_WINDOWS)
    z32 = z.astype(f32).reshape(nb, n, ng, POOL_CH)
    cs = jnp.concatenate([jnp.zeros((nb, 1, ng, POOL_CH), f32), jnp.cumsum(z32, axis=1)], axis=1)
    t = jnp.arange(n)
    pooled = []
    for g, w in enumerate(POOL_WINDOWS):
        lo = jnp.clip(t - w // 2, 0, n)
        hi = jnp.clip(t + w - w // 2, 0, n)
        win_sum = jnp.take(cs[:, :, g], hi, axis=1) - jnp.take(cs[:, :, g], lo, axis=1)
        pooled.append(win_sum / (hi - lo).astype(f32)[None, :, None])
    p = jnp.stack(pooled, 2) - z32
    y = jnp.einsum("blgc,gcd->blgd", p, pool_w.astype(f32)).reshape(nb, n, GROUP_W)
    return y * pool_scale.astype(f32)


def sgu_mixer(z, sgu_w, sgu_b):
    f32 = jnp.float32
    nb, n, _ = z.shape
    z = jax.nn.gelu(z.astype(f32))
    u, v = z[..., :GROUP_W], z[..., GROUP_W:]
    v = v.reshape(nb, n // SGU_CHUNK, SGU_CHUNK, SGU_HEADS, SGU_CH)
    mu = jnp.mean(v, -1, keepdims=True)
    var = jnp.mean(jnp.square(v - mu), -1, keepdims=True)
    v = (v - mu) * lax.rsqrt(var + LN_EPS)
    s = jnp.einsum("bnsgc,gts->bntgc", v, sgu_w.astype(f32)) + sgu_b.astype(f32).T[None, None, :, :, None]
    return u * s.reshape(nb, n, GROUP_W)


def token_mixers(h, lp, h0_re, h0_im):
    nb, n, _ = h.shape
    z = h @ lp["w_mix_in"]
    z_a = z[..., :GROUP_W]
    z_b = z[..., GROUP_W:2 * GROUP_W]
    z_c = z[..., 2 * GROUP_W:3 * GROUP_W]
    z_d = z[..., 3 * GROUP_W:]
    y_a, fin_re, fin_im = s5_mixer(z_a, lp["ssm_lam_re"], lp["ssm_lam_im"], lp["ssm_log_dt"],
                                   lp["ssm_b_re"], lp["ssm_b_im"], lp["ssm_c_re"], lp["ssm_c_im"],
                                   lp["ssm_d"], lp["ssm_glu_w"], lp["ssm_glu_b"], h0_re, h0_im)
    y_b = fnet_mixer(z_b, lp["fnet_w"])
    y_c = pool_mixer(z_c, lp["pool_w"], lp["pool_scale"])
    y_d = sgu_mixer(z_d, lp["sgu_w"], lp["sgu_b"])
    y = jnp.stack([y_a, y_b, y_c, y_d], axis=2)
    y = y * lax.rsqrt(jnp.mean(jnp.square(y), -1, keepdims=True) + LN_EPS)
    y = y.reshape(nb, n, MIX_W) * lp["mix_norm_g"].astype(jnp.float32)
    return y.astype(h.dtype) @ lp["w_mix_out"], fin_re, fin_im


def modulation(cond, w_ada, b_ada):
    return (jax.nn.silu(cond) @ w_ada + b_ada).reshape(cond.shape[0], N_MOD, D_MODEL)


def trunk_layer(x, mod, lp, h0_re, h0_im):
    m = [mod[:, k][:, None, :] for k in range(N_MOD)]
    h = x * (1.0 + m[1]) + m[0]
    x = layer_norm(ALPHA * x + 0.5 * m[2] * swiglu(h, lp["ffn_w_in"][0], lp["ffn_w_out"][0]),
                   lp["ln_g"][0], lp["ln_b"][0])
    h = x * (1.0 + m[4]) + m[3]
    y, fin_re, fin_im = token_mixers(h, lp, h0_re, h0_im)
    x = layer_norm(ALPHA * x + m[5] * y, lp["ln_g"][1], lp["ln_b"][1])
    h = x * (1.0 + m[7]) + m[6]
    x = layer_norm(ALPHA * x + 0.5 * m[8] * swiglu(h, lp["ffn_w_in"][1], lp["ffn_w_out"][1]),
                   lp["ln_g"][2], lp["ln_b"][2])
    return x, fin_re, fin_im


def setup_inputs(seed: int = 0) -> dict:
    key = jax.random.key(seed)
    ks = jax.random.split(key, 32)
    f32 = jnp.float32
    nrm = lambda k, shape, s: jax.random.normal(k, shape, f32) * s
    st_shape = (DEC_BATCH, DEPTH, 2, SSM_GROUPS, SSM_STATE)
    lam_im = jnp.broadcast_to(math.pi * jnp.arange(SSM_STATE, dtype=f32), (DEPTH, 2, SSM_GROUPS, SSM_STATE))
    return {
        "x_prompt": nrm(ks[0], (BATCH, SEQ, D_MODEL), 1.0),
        "x_sample": nrm(ks[1], (DEC_BATCH, DEC_SEQ, D_MODEL), 1.0),
        "c": nrm(ks[2], (DEC_BATCH, D_MODEL), 1.0),
        "state_s5_re": nrm(ks[3], st_shape, 0.1),
        "state_s5_im": nrm(ks[4], st_shape, 0.1),
        "c_ctx": nrm(ks[5], (D_MODEL,), 1.0),
        "w_ada": nrm(ks[6], (DEPTH, D_MODEL, N_MOD * D_MODEL), 0.5 * D_MODEL ** -0.5),
        "b_ada": nrm(ks[7], (DEPTH, N_MOD * D_MODEL), 0.01),
        "ffn_w_in": nrm(ks[8], (DEPTH, 2, D_MODEL, 2 * D_FF), D_MODEL ** -0.5),
        "ffn_w_out": nrm(ks[9], (DEPTH, 2, D_FF, D_MODEL), BETA * D_FF ** -0.5),
        "w_mix_in": nrm(ks[10], (DEPTH, D_MODEL, IN_COLS), D_MODEL ** -0.5),
        "w_mix_out": nrm(ks[11], (DEPTH, MIX_W, D_MODEL), BETA * MIX_W ** -0.5),
        "mix_norm_g": 1.0 + nrm(ks[12], (DEPTH, MIX_W), 0.01),
        "ssm_lam_re": -0.5 + nrm(ks[13], (DEPTH, 2, SSM_GROUPS, SSM_STATE), 0.01),
        "ssm_lam_im": lam_im + nrm(ks[14], (DEPTH, 2, SSM_GROUPS, SSM_STATE), 0.01),
        "ssm_log_dt": jax.random.uniform(ks[15], (DEPTH, 2, SSM_GROUPS), f32, math.log(1e-3), math.log(1e-1)),
        "ssm_b_re": nrm(ks[16], (DEPTH, 2, SSM_GROUPS, SSM_STATE, SSM_CH), (2 * SSM_CH) ** -0.5),
        "ssm_b_im": nrm(ks[17], (DEPTH, 2, SSM_GROUPS, SSM_STATE, SSM_CH), (2 * SSM_CH) ** -0.5),
        "ssm_c_re": nrm(ks[18], (DEPTH, 2, SSM_GROUPS, SSM_CH, SSM_STATE), (2 * SSM_STATE) ** -0.5),
        "ssm_c_im": nrm(ks[19], (DEPTH, 2, SSM_GROUPS, SSM_CH, SSM_STATE), (2 * SSM_STATE) ** -0.5),
        "ssm_d": nrm(ks[20], (DEPTH, GROUP_W), 1.0),
        "ssm_glu_w": nrm(ks[21], (DEPTH, GROUP_W, GROUP_W), GROUP_W ** -0.5),
        "ssm_glu_b": nrm(ks[22], (DEPTH, GROUP_W), 0.01),
        "fnet_w": nrm(ks[23], (DEPTH, FNET_HEADS, FNET_CH, FNET_CH), FNET_CH ** -0.5),
        "pool_w": nrm(ks[24], (DEPTH, len(POOL_WINDOWS), POOL_CH, POOL_CH), POOL_CH ** -0.5),
        "pool_scale": 1.0 + nrm(ks[25], (DEPTH, GROUP_W), 0.1),
        "sgu_w": nrm(ks[26], (DEPTH, SGU_HEADS, SGU_CHUNK, SGU_CHUNK), SGU_CHUNK ** -0.5),
        "sgu_b": 1.0 + nrm(ks[27], (DEPTH, SGU_HEADS, SGU_CHUNK), 0.01),
        "ln_g": 1.0 + nrm(ks[28], (DEPTH, 3, D_MODEL), 0.01),
        "ln_b": nrm(ks[29], (DEPTH, 3, D_MODEL), 0.01),
    }


def reference(x_prompt, x_sample, c, state_s5_re, state_s5_im, c_ctx, w_ada, b_ada, ffn_w_in, ffn_w_out,
              w_mix_in, w_mix_out, mix_norm_g, ssm_lam_re, ssm_lam_im, ssm_log_dt, ssm_b_re, ssm_b_im,
              ssm_c_re, ssm_c_im, ssm_d, ssm_glu_w, ssm_glu_b, fnet_w, pool_w, pool_scale, sgu_w, sgu_b,
              ln_g, ln_b):
    n_ctx_batch = x_prompt.shape[0]
    cond_ctx = jnp.broadcast_to(c_ctx, (n_ctx_batch, D_MODEL))
    zero_state = jnp.zeros((n_ctx_batch, 2, SSM_GROUPS, SSM_STATE), jnp.float32)
    xp = x_prompt
    xs = x_sample + sincos_2d(x_sample.shape[1]).astype(x_sample.dtype)[None]
    new_re, new_im = [], []
    for i in range(DEPTH):
        lp = {
            "ffn_w_in": ffn_w_in[i], "ffn_w_out": ffn_w_out[i],
            "w_mix_in": w_mix_in[i], "w_mix_out": w_mix_out[i], "mix_norm_g": mix_norm_g[i],
            "ssm_lam_re": ssm_lam_re[i], "ssm_lam_im": ssm_lam_im[i], "ssm_log_dt": ssm_log_dt[i],
            "ssm_b_re": ssm_b_re[i], "ssm_b_im": ssm_b_im[i], "ssm_c_re": ssm_c_re[i], "ssm_c_im": ssm_c_im[i],
            "ssm_d": ssm_d[i], "ssm_glu_w": ssm_glu_w[i], "ssm_glu_b": ssm_glu_b[i],
            "fnet_w": fnet_w[i], "pool_w": pool_w[i], "pool_scale": pool_scale[i],
            "sgu_w": sgu_w[i], "sgu_b": sgu_b[i], "ln_g": ln_g[i], "ln_b": ln_b[i],
        }
        xp, fin_re, fin_im = trunk_layer(xp, modulation(cond_ctx, w_ada[i], b_ada[i]), lp,
                                         zero_state, zero_state)
        new_re.append(fin_re)
        new_im.append(fin_im)
        xs, _, _ = trunk_layer(xs, modulation(c, w_ada[i], b_ada[i]), lp,
                               state_s5_re[:, i], state_s5_im[:, i])
    new_s5_re = jnp.stack(new_re, axis=1)
    new_s5_im = jnp.stack(new_im, axis=1)
    return (xp, xs, new_s5_re, new_s5_im)
```

```cpp
#include <hip/hip_runtime.h>
#include <hip/hip_cooperative_groups.h>
#include <cstdio>
namespace cg = cooperative_groups;
namespace pg8 {
#define PG8_LAS __attribute__((address_space(3)))
typedef unsigned short bf16_t;
typedef short bf16x8 __attribute__((ext_vector_type(8)));
typedef float f32x4 __attribute__((ext_vector_type(4)));
typedef unsigned u32x4 __attribute__((ext_vector_type(4)));
constexpr int BM = 256, BK = 64, HALF = 128, HTB = HALF * BK * 2  , STAGE_BYTES = 8 * HTB, NXCD = 8, WGM = 8;

__host__ __device__ __forceinline__ int lds_byte(int r, int c) { const int st = (r >> 4) * 2 + (c >> 5), rr = r & 15, cc = c & 31, ob = rr * 64 + cc * 2; return st * 1024 + (ob ^ (((ob >> 9) & 1) << 5)); }
__host__ __device__ __forceinline__ void stage_rc(int b, int& R, int& C) { const int st = b / 1024, sb = b % 1024, swz = sb ^ (((sb >> 9) & 1) << 5); R = (st >> 1) * 16 + swz / 64; C = (st & 1) * 32 + (swz % 64) / 2; }
__host__ __device__ __forceinline__ int perm32(int rho) { const int n = rho >> 4, i = rho & 15; return 8 * (i >> 2) + 4 * n + (i & 3); }

struct Unit { int pm, pn; };
struct Gemm { const bf16_t* A; const bf16_t* Bt; int M, N, K; };

struct StaticOrder {
    int nM, nN, nwg, G, c;
    __host__ __device__ void init(int M, int N, int G_, int c_) { nM = M / BM; nN = N / BM; nwg = nM * nN; G = G_; c = c_; }
    __host__ __device__ bool next(int i, Unit& u) const {
        const long L = (long)i * G + c; if (L >= nwg) return false;
        int wgid = (int)L; { const int q = nwg / NXCD, r = nwg % NXCD, xcd = wgid % NXCD, off = wgid / NXCD; wgid = (xcd < r ? xcd * (q + 1) : r * (q + 1) + (xcd - r) * q) + off; }
        const int nig = WGM * nN, gid = wgid / nig, fm = gid * WGM, gsz = (nM - fm) < WGM ? (nM - fm) : WGM;
        u.pm = fm + ((wgid % nig) % gsz); u.pn = (wgid % nig) / gsz; return true;
    }
    __device__ __forceinline__ void a_ready(const Unit&) const {}
    __device__ __forceinline__ void done(const Unit&) const {}
};
__device__ __forceinline__ unsigned cvt_pk_bf16(float lo, float hi) { unsigned r; asm volatile("v_cvt_pk_bf16_f32 %0, %1, %2" : "=v"(r) : "v"(lo), "v"(hi)); return r; }
typedef float f32x2 __attribute__((ext_vector_type(2)));
template <class Epi, class Sched, bool STAMP = false>
__device__ __forceinline__ void gemm_phase(PG8_LAS unsigned char* lds, const Gemm g, const Sched& S, const Epi& E, unsigned long long* stamps) {
    int tid_o = threadIdx.x; asm volatile("" : "+v"(tid_o));
    const int tid = tid_o, wid = __builtin_amdgcn_readfirstlane(tid >> 6), lane = tid & 63, wr = wid >> 2, wc = wid & 3, fr = lane & 15, fq = lane >> 4;
    const int K = g.K, nt = K / BK;
    int ts_lo = 0, ts_hi = 0, nts = 0; const unsigned long long rt_entry = STAMP ? (unsigned long long)wall_clock64() : 0ull;
#define PG8_STAMP() do { if (STAMP && wid == 0 && nts < 64) { const unsigned long long _c = (unsigned long long)clock64(); \
        ts_lo = (lane == nts) ? (int)(unsigned)_c : ts_lo; ts_hi = (lane == nts) ? (int)(unsigned)(_c >> 32) : ts_hi; ++nts; } } while (0)
    PG8_STAMP();
    unsigned voffA[2], voffB[2];
#pragma unroll
    for (int i = 0; i < 2; ++i) { int R, C; stage_rc(tid * 16 + i * 8192, R, C); const int Rb = Epi::PERM ? ((R & ~31) + perm32(R & 31)) : R;
        voffA[i] = (unsigned)(R * K + C) * 2u; voffB[i] = (unsigned)(Rb * K + C) * 2u; }
    const size_t kstep = (size_t)(BK * 2);
    const size_t hstep = (size_t)HALF * K * 2;
    const size_t tstep = 2 * hstep;
    const unsigned ldsw = (unsigned)wid * 1024u;
    const int aoff = lds_byte(wr * 64 + fr, fq * 8), boff = lds_byte(wc * 32 + fr, fq * 8);
#define PG8_SA(b, h) (((b) * 2 + (h)) * HTB)
#define PG8_SB(b, h) ((4 + (b) * 2 + (h)) * HTB)
#define PG8_STAGE(bufoff, gbase, voff) do { _Pragma("unroll") for (int _i = 0; _i < 2; ++_i) \
        __builtin_amdgcn_global_load_lds((const unsigned*)((const char*)(gbase) + (voff)[_i]), (PG8_LAS unsigned*)(lds + (bufoff) + ldsw + _i * 8192), 16, 0, 0); } while (0)
#define PG8_LDA(dst, b, h) do { _Pragma("unroll") for (int m = 0; m < 4; ++m) _Pragma("unroll") for (int k = 0; k < 2; ++k) dst[m][k] = *(const PG8_LAS bf16x8*)(lds + PG8_SA(b, h) + aoff + m * 2048 + k * 1024); } while (0)
#define PG8_LDB(dst, b, h) do { _Pragma("unroll") for (int n = 0; n < 2; ++n) _Pragma("unroll") for (int k = 0; k < 2; ++k) dst[n][k] = *(const PG8_LAS bf16x8*)(lds + PG8_SB(b, h) + boff + n * 2048 + k * 1024); } while (0)
#define PG8_MMA(ai, bj, At, Bt) do { __builtin_amdgcn_s_setprio(1); _Pragma("unroll") for (int m = 0; m < 4; ++m) _Pragma("unroll") for (int n = 0; n < 2; ++n) _Pragma("unroll") for (int k = 0; k < 2; ++k) \
        acc[ai][bj][m][n] = __builtin_amdgcn_mfma_f32_16x16x32_bf16(Bt[n][k], At[m][k], acc[ai][bj][m][n], 0, 0, 0); __builtin_amdgcn_s_setprio(0); } while (0)
#define PG8_WAIT_V(n) asm volatile("s_waitcnt vmcnt(" #n ")" ::: "memory")
#define PG8_WAIT_L(n) asm volatile("s_waitcnt lgkmcnt(" #n ")" ::: "memory")
#define PG8_BAR __builtin_amdgcn_s_barrier()
#define PG8_SCHED __builtin_amdgcn_sched_barrier(0)
    Unit cur, nxt; int ui = 0;
    if (!S.next(0, cur)) return;
    f32x4 acc[2][2][4][2];
#pragma unroll
    for (int a = 0; a < 2; ++a)
#pragma unroll
        for (int b = 0; b < 2; ++b)
#pragma unroll
            for (int m = 0; m < 4; ++m)
#pragma unroll
                for (int n = 0; n < 2; ++n) acc[a][b][m][n] = (f32x4){0.f, 0.f, 0.f, 0.f};
    bf16x8 At[4][2], B0[2][2], B1[2][2];
    const char* cA = (const char*)g.A + (size_t)cur.pm * tstep; const char* cB = (const char*)g.Bt + (size_t)cur.pn * tstep;
    S.a_ready(cur);
    PG8_STAGE(PG8_SB(0, 0), cB, voffB); PG8_STAGE(PG8_SA(0, 0), cA, voffA); PG8_STAGE(PG8_SB(0, 1), cB + hstep, voffB); PG8_STAGE(PG8_SA(0, 1), cA + hstep, voffA);
    if (wr == 1) PG8_BAR;
    PG8_WAIT_V(4); PG8_BAR;
    PG8_STAGE(PG8_SB(1, 0), cB + kstep, voffB); PG8_STAGE(PG8_SA(1, 0), cA + kstep, voffA); PG8_STAGE(PG8_SB(1, 1), cB + hstep + kstep, voffB);
    PG8_WAIT_V(6); PG8_BAR;
    PG8_STAMP();
    for (;;) {
        const bool has_next = S.next(ui + 1, nxt);
        const char* nA = has_next ? (const char*)g.A + (size_t)nxt.pm * tstep : cA; const char* nB = has_next ? (const char*)g.Bt + (size_t)nxt.pn * tstep : cB;
        for (int t = 0; t < nt; t += 2) {
            const bool last = (t == nt - 2);
            const char* a1 = cA + (size_t)(t + 1) * kstep;
            const char* a2 = last ? nA : cA + (size_t)(t + 2) * kstep; const char* b2 = last ? nB : cB + (size_t)(t + 2) * kstep;
            const char* a3 = a2 + kstep; const char* b3 = b2 + kstep;
            if (last && has_next) S.a_ready(nxt);
            PG8_LDB(B0, 0, 0); PG8_SCHED; PG8_LDA(At, 0, 0); PG8_STAGE(PG8_SA(1, 1), a1 + hstep, voffA);
            PG8_WAIT_L(8); PG8_BAR; PG8_WAIT_L(0); PG8_MMA(0, 0, At, B0); PG8_BAR; PG8_SCHED;
            PG8_LDB(B1, 0, 1); PG8_STAGE(PG8_SB(0, 0), b2, voffB);
            PG8_BAR; PG8_WAIT_L(0); PG8_MMA(0, 1, At, B1); PG8_BAR;
            PG8_LDA(At, 0, 1); PG8_STAGE(PG8_SA(0, 0), a2, voffA);
            PG8_BAR; PG8_WAIT_L(0); PG8_MMA(1, 0, At, B0); PG8_BAR; PG8_SCHED;
            PG8_STAGE(PG8_SB(0, 1), b2 + hstep, voffB);
            PG8_WAIT_V(6); PG8_BAR; PG8_MMA(1, 1, At, B1); PG8_BAR;
            PG8_LDB(B0, 1, 0); PG8_SCHED; PG8_LDA(At, 1, 0); PG8_STAGE(PG8_SA(0, 1), a2 + hstep, voffA);
            PG8_WAIT_L(8); PG8_BAR; PG8_WAIT_L(0); PG8_MMA(0, 0, At, B0); PG8_BAR; PG8_SCHED;
            PG8_LDB(B1, 1, 1); PG8_STAGE(PG8_SB(1, 0), b3, voffB);
            PG8_BAR; PG8_WAIT_L(0); PG8_MMA(0, 1, At, B1); PG8_BAR;
            PG8_LDA(At, 1, 1); PG8_STAGE(PG8_SA(1, 0), a3, voffA);
            PG8_BAR; PG8_WAIT_L(0); PG8_MMA(1, 0, At, B0); PG8_BAR; PG8_SCHED;
            PG8_STAGE(PG8_SB(1, 1), b3 + hstep, voffB);
            PG8_WAIT_V(6); PG8_BAR; PG8_MMA(1, 1, At, B1); PG8_BAR;
        }
        PG8_STAMP();
        if constexpr (!Epi::AFTER_DRAIN) { E(acc, cur, wr, wc, fr, fq); S.done(cur); }
        PG8_STAMP();
        if (!has_next) break;
#pragma unroll
        for (int a = 0; a < 2; ++a)
#pragma unroll
            for (int b = 0; b < 2; ++b)
#pragma unroll
                for (int m = 0; m < 4; ++m)
#pragma unroll
                    for (int n = 0; n < 2; ++n) acc[a][b][m][n] = (f32x4){0.f, 0.f, 0.f, 0.f};
        cur = nxt; cA = nA; cB = nB; ++ui;
    }
    PG8_WAIT_V(0);
    if (wr == 0) PG8_BAR;
    PG8_BAR;
    if constexpr (Epi::AFTER_DRAIN) { E.fused(acc, cur, wr, wc, fr, fq, lds, wid, lane); S.done(cur); }
    PG8_STAMP();
    if (STAMP && wid == 0) { stamps[lane] = lane < nts ? (((unsigned long long)(unsigned)ts_hi << 32) | (unsigned)ts_lo) : 0ull;
        if (lane == 62) stamps[62] = rt_entry; if (lane == 63) stamps[63] = (unsigned long long)wall_clock64(); }
#undef PG8_STAMP
#undef PG8_SA
#undef PG8_SB
#undef PG8_STAGE
#undef PG8_LDA
#undef PG8_LDB
#undef PG8_MMA
#undef PG8_WAIT_V
#undef PG8_WAIT_L
#undef PG8_BAR
#undef PG8_SCHED
}
}

using pg8::bf16_t; using pg8::bf16x8; using pg8::f32x4; using pg8::u32x4; using pg8::Unit; using pg8::cvt_pk_bf16;
typedef float f32x16 __attribute__((ext_vector_type(16)));
typedef float f32x2v __attribute__((ext_vector_type(2)));
typedef unsigned u32x2 __attribute__((ext_vector_type(2)));
#define LAS PG8_LAS

constexpr int D = 1024, MCTX = 4096, MTOT = 36864, DFF = 2816, NFI = 5632, NMI = 1536;
constexpr float ALPHA = 1.6817928305074290f;
constexpr float LN_EPS = 1e-5f;
constexpr int LDS_BYTES = 131072;
constexpr int OUT_RE = MTOT * D, OUT_IM = OUT_RE + 16 * 4 * 2 * 16 * 64, OUT_TOTAL = OUT_IM + 16 * 4 * 2 * 16 * 64;

constexpr size_t al256(size_t x) { return (x + 255) & ~(size_t)255; }
constexpr size_t WS_WFI = 0;
constexpr size_t WS_WFO = WS_WFI + (size_t)8 * NFI * D * 2;
constexpr size_t WS_WMI = WS_WFO + (size_t)8 * D * DFF * 2;
constexpr size_t WS_WMO = WS_WMI + (size_t)4 * NMI * D * 2;
constexpr size_t WS_WGLU = WS_WMO + (size_t)4 * D * D * 2;
constexpr size_t WS_WSGU = WS_WGLU + (size_t)4 * 256 * 256 * 2;
constexpr size_t WS_MOD = WS_WSGU + (size_t)4 * 4 * 128 * 128 * 2;
constexpr size_t WS_DL = al256(WS_MOD + (size_t)4 * 9 * 9216 * 4);
constexpr size_t WS_DC = WS_DL + (size_t)4096 * 8192 * 2;
constexpr size_t WS_S5A = WS_DC + (size_t)256 * 512 * 2;
constexpr size_t WS_S5B = WS_S5A + (size_t)128 * 64 * 8;
constexpr size_t WS_S5C = WS_S5B + (size_t)128 * 128 * 16 * 2;
constexpr size_t WS_STATS = WS_S5C + (size_t)128 * 16 * 128 * 2;
constexpr size_t WS_H = WS_STATS + (size_t)MTOT * 2 * 4;
constexpr size_t WS_BIG = WS_H + (size_t)MTOT * D * 2;
constexpr size_t WS_ACT = WS_BIG;
constexpr size_t WS_Z = WS_BIG;
constexpr size_t WS_PTL = WS_Z + (size_t)MTOT * D * 2;
constexpr size_t WS_PTC = WS_PTL + (size_t)2048 * 8192 * 2;
constexpr size_t WS_YF = WS_PTC + (size_t)4096 * 512 * 2;
constexpr size_t WS_YB = WS_YF + (size_t)MTOT * 256 * 2;
constexpr size_t WS_YA = WS_YB + (size_t)MTOT * 256 * 2;
constexpr size_t WS_VNT = WS_YA + (size_t)MTOT * 256 * 2;
constexpr size_t WS_YCAT = WS_VNT + (size_t)1152 * 64 * 128 * 2;
constexpr size_t WS_END_MIX = WS_YCAT + (size_t)MTOT * D * 2;
constexpr size_t WS_END_ACT = WS_ACT + (size_t)MTOT * DFF * 2;
constexpr size_t WS_END = WS_END_MIX > WS_END_ACT ? WS_END_MIX : WS_END_ACT;

struct Args { const float* in[30]; float* out; unsigned char* ws; };

typedef const float* cfp_t;
typedef const __attribute__((address_space(4))) unsigned char* kaptr_t;
__device__ __forceinline__ const unsigned char* ka_load(int byte_off) {
    kaptr_t ka = (kaptr_t)__builtin_amdgcn_kernarg_segment_ptr(); asm volatile("" : "+s"(ka));
    return *(const unsigned char* const __attribute__((address_space(4)))*)(ka + byte_off);
}
struct InProxy { __device__ __forceinline__ const float* operator[](int i) const { return (const float*)ka_load(8 * i); } };
struct Ctx {
    InProxy in;
    float* out;
    unsigned char* ws;
    __device__ __forceinline__ float* v() const { return out; }
    __device__ __forceinline__ bf16_t* wfi() const { return (bf16_t*)(ws + WS_WFI); }
    __device__ __forceinline__ bf16_t* wfo() const { return (bf16_t*)(ws + WS_WFO); }
    __device__ __forceinline__ bf16_t* wmi() const { return (bf16_t*)(ws + WS_WMI); }
    __device__ __forceinline__ bf16_t* wmo() const { return (bf16_t*)(ws + WS_WMO); }
    __device__ __forceinline__ bf16_t* wglu() const { return (bf16_t*)(ws + WS_WGLU); }
    __device__ __forceinline__ bf16_t* wsgu() const { return (bf16_t*)(ws + WS_WSGU); }
    __device__ __forceinline__ float* mod() const { return (float*)(ws + WS_MOD); }
    __device__ __forceinline__ bf16_t* dl() const { return (bf16_t*)(ws + WS_DL); }
    __device__ __forceinline__ bf16_t* dc() const { return (bf16_t*)(ws + WS_DC); }
    __device__ __forceinline__ f32x2v* s5a() const { return (f32x2v*)(ws + WS_S5A); }
    __device__ __forceinline__ bf16_t* s5b() const { return (bf16_t*)(ws + WS_S5B); }
    __device__ __forceinline__ bf16_t* s5c() const { return (bf16_t*)(ws + WS_S5C); }
    __device__ __forceinline__ f32x2v* stats() const { return (f32x2v*)(ws + WS_STATS); }
    __device__ __forceinline__ bf16_t* h() const { return (bf16_t*)(ws + WS_H); }
    __device__ __forceinline__ bf16_t* act() const { return (bf16_t*)(ws + WS_ACT); }
    __device__ __forceinline__ bf16_t* z() const { return (bf16_t*)(ws + WS_Z); }
    __device__ __forceinline__ bf16_t* ptl() const { return (bf16_t*)(ws + WS_PTL); }
    __device__ __forceinline__ bf16_t* ptc() const { return (bf16_t*)(ws + WS_PTC); }
    __device__ __forceinline__ bf16_t* yf() const { return (bf16_t*)(ws + WS_YF); }
    __device__ __forceinline__ bf16_t* yb() const { return (bf16_t*)(ws + WS_YB); }
    __device__ __forceinline__ bf16_t* ya() const { return (bf16_t*)(ws + WS_YA); }
    __device__ __forceinline__ bf16_t* vnt() const { return (bf16_t*)(ws + WS_VNT); }
    __device__ __forceinline__ bf16_t* ycat() const { return (bf16_t*)(ws + WS_YCAT); }
};
#define OPAQUE_CTX(X, Xin) Ctx X; X.out = (float*)ka_load(240); X.ws = (unsigned char*)ka_load(248); (void)Xin


__device__ __forceinline__ float bf2f(bf16_t x) { return __uint_as_float(((unsigned)x) << 16); }
__device__ __forceinline__ float bflo(unsigned w) { return __uint_as_float(w << 16); }
__device__ __forceinline__ float bfhi(unsigned w) { return __uint_as_float(w & 0xffff0000u); }
__device__ __forceinline__ bf16_t f2bf(float x) { return (bf16_t)(cvt_pk_bf16(x, 0.f) & 0xffffu); }
__device__ __forceinline__ float sigmoidf_(float x) { return 1.0f / (1.0f + __expf(-x)); }
__device__ __forceinline__ float siluf_(float x) { return x / (1.0f + __expf(-x)); }
__device__ __forceinline__ float geluf_(float x) { const float t = 1.5957691216057308f * (x + 0.044715f * x * x * x); return x / (1.0f + __expf(-t)); }
__device__ __forceinline__ int otid() { int t = threadIdx.x; asm volatile("" : "+v"(t)); return t; }
__device__ __forceinline__ float wave_sum(float x) {
#pragma unroll
    for (int o = 32; o > 0; o >>= 1) x += __shfl_xor(x, o);
    return x;
}

__device__ __forceinline__ void tconv_tile(LAS float* tile, const float* src, int ldsrc, int k0, int n0src, bf16_t* dst, int lddst, int n0dst) {
    const int t = otid();
#pragma unroll
    for (int i = 0; i < 2; ++i) {
        const int r = (t >> 4) + 32 * i, c = (t & 15) * 4;
        const f32x4 v = *(const f32x4*)(src + (size_t)(k0 + r) * ldsrc + n0src + c);
        tile[r * 65 + c + 0] = v[0]; tile[r * 65 + c + 1] = v[1]; tile[r * 65 + c + 2] = v[2]; tile[r * 65 + c + 3] = v[3];
    }
    __syncthreads();
    {
        const int n = t >> 3, k8 = (t & 7) * 8;
        float x[8];
#pragma unroll
        for (int j = 0; j < 8; ++j) x[j] = tile[(k8 + j) * 65 + n];
        u32x4 w; w.x = cvt_pk_bf16(x[0], x[1]); w.y = cvt_pk_bf16(x[2], x[3]); w.z = cvt_pk_bf16(x[4], x[5]); w.w = cvt_pk_bf16(x[6], x[7]);
        *(u32x4*)(dst + (size_t)(n0dst + n) * lddst + k0 + k8) = w;
    }
    __syncthreads();
}

__device__ __forceinline__ void phase0(const Ctx& Xin, LAS unsigned char* lds) {
    OPAQUE_CTX(X, Xin);
    const int tid = otid(), lane = tid & 63, wave = tid >> 6, G = gridDim.x, bid = blockIdx.x;
#ifndef P0MASK
#define P0MASK 0xFF
#endif
#define P0(k) if ((P0MASK >> (k)) & 1)
    P0(0) {
        LAS float* tile = (LAS float*)lds;
        for (int it = bid; it < 18752; it += G) {
            const float* src; bf16_t* dst; int ldsrc, lddst, k0, n0s, n0d;
            if (it < 11264) { const int li = it / 1408, rem = it % 1408, kt = rem / 88, nt = rem % 88;
                src = X.in[8] + (size_t)li * D * NFI; ldsrc = NFI; dst = X.wfi() + (size_t)li * NFI * D; lddst = D; k0 = kt * 64; n0s = nt * 64;
                if (n0s < DFF) n0d = (n0s >> 7) * 256 + (n0s & 127); else { const int j = n0s - DFF; n0d = (j >> 7) * 256 + 128 + (j & 127); } }
            else if (it < 16896) { const int i2 = it - 11264, li = i2 / 704, rem = i2 % 704, kt = rem / 16, nt = rem % 16;
                src = X.in[9] + (size_t)li * DFF * D; ldsrc = D; dst = X.wfo() + (size_t)li * D * DFF; lddst = DFF; k0 = kt * 64; n0s = nt * 64; n0d = n0s; }
            else if (it < 17152) { const int i2 = it - 16896, l = i2 / 64, rem = i2 % 64, kt = rem / 4, nt = rem % 4;
                src = X.in[10] + (size_t)l * D * 1280; ldsrc = 1280; dst = X.wmi() + (size_t)l * NMI * D; lddst = D; k0 = kt * 64; n0s = nt * 64; n0d = n0s; }
            else if (it < 17664) { const int i2 = it - 17152, l = i2 / 128, rem = i2 % 128, kt = rem / 8, nt = rem % 8;
                src = X.in[10] + (size_t)l * D * 1280; ldsrc = 1280; dst = X.wmi() + (size_t)l * NMI * D; lddst = D; k0 = kt * 64; n0s = 768 + nt * 64; n0d = 1024 + nt * 64; }
            else if (it < 18688) { const int i2 = it - 17664, l = i2 / 256, rem = i2 % 256, kt = rem / 16, nt = rem % 16;
                src = X.in[11] + (size_t)l * D * D; ldsrc = D; dst = X.wmo() + (size_t)l * D * D; lddst = D; k0 = kt * 64; n0s = nt * 64; n0d = n0s; }
            else { const int i2 = it - 18688, l = i2 / 16, rem = i2 % 16, kt = rem / 4, nt = rem % 4;
                src = X.in[21] + (size_t)l * 65536; ldsrc = 256; dst = X.wglu() + (size_t)l * 65536; lddst = 256; k0 = kt * 64; n0s = nt * 64; n0d = n0s; }
            tconv_tile(tile, src, ldsrc, k0, n0s, dst, lddst, n0d);
        }
    }
    __syncthreads();
    P0(1) {
        LAS float* T = (LAS float*)lds;
        LAS float* ctab = (LAS float*)(lds + 32768);
        for (int u = bid; u < 256; u += G) {
            const int layer = u >> 6, kind = (u >> 3) & 7, kb = u & 7;
            if (tid < 64) ctab[tid] = cospif((float)tid * (1.0f / 32.0f));
            __syncthreads();
            if (kind < 4) {
                const float* fw = X.in[23] + (size_t)(layer * 4 + kind) * 4096;
                for (int e = tid; e < 8192; e += 512) {
                    const int c = e >> 7, j = e & 127, d = j & 63, sn = j >> 6;
                    float acc = 0.f;
                    for (int cp = 0; cp < 64; ++cp) { const int m = (c * cp - 16 * sn) & 63; acc += ctab[m] * fw[cp * 64 + d]; }
                    T[e] = acc;
                }
            } else {
                const float* pw = X.in[24] + (size_t)(layer * 4 + (kind - 4)) * 4096;
                for (int e = tid; e < 8192; e += 512) { const int c = e >> 7, j = e & 127; T[e] = (j < 64) ? pw[c * 64 + j] : 0.f; }
            }
            __syncthreads();
            {
                const int k = kb * 128 + (tid & 127), js = tid >> 7;
                const int coff = (kind < 4) ? 256 + kind * 64 : 512 + (kind - 4) * 64;
                const float* wr = X.in[10] + ((size_t)(layer * D + k)) * 1280 + coff;
                bf16_t* dstl = X.wmi() + (size_t)layer * NMI * D;
                f32x4 acc[8];
#pragma unroll
                for (int q = 0; q < 8; ++q) acc[q] = (f32x4){0.f, 0.f, 0.f, 0.f};
#pragma unroll 2
                for (int c = 0; c < 64; ++c) {
                    const float w = wr[c];
#pragma unroll
                    for (int q = 0; q < 8; ++q) acc[q] += w * *(LAS f32x4*)(T + c * 128 + js * 32 + q * 4);
                }
#pragma unroll
                for (int q = 0; q < 8; ++q)
#pragma unroll
                    for (int e = 0; e < 4; ++e) {
                        const int jc = js * 32 + q * 4 + e;
                        int n;
                        if (kind < 4) n = (jc < 64) ? (256 + kind * 64 + jc) : (512 + kind * 64 + (jc - 64));
                        else n = 768 + (kind - 4) * 64 + jc;
                        if (kind < 4 || jc < 64) dstl[(size_t)n * D + k] = f2bf(acc[q][e]);
                    }
            }
            __syncthreads();
        }
    }
    __syncthreads();
    P0(2) {
        LAS float* sv = (LAS float*)lds;
        LAS float* part = (LAS float*)(lds + 36864);
        for (int e = tid; e < 9 * 1024; e += 512) { const int cnd = e >> 10, k = e & 1023; const float c = (cnd < 8) ? X.in[2][cnd * 1024 + k] : X.in[5][k]; sv[e] = siluf_(c); }
        __syncthreads();
        for (int u = bid; u < 288; u += G) {
            const int layer = u / 72, chunk = u % 72, col = chunk * 128 + 2 * lane;
            float ax[9], ay[9];
#pragma unroll
            for (int c = 0; c < 9; ++c) { ax[c] = 0.f; ay[c] = 0.f; }
            const float* wp = X.in[6] + ((size_t)(layer * D + wave * 128)) * 9216 + col;
            for (int k = 0; k < 128; ++k) {
                const f32x2v wv = *(const f32x2v*)(wp + (size_t)k * 9216);
#pragma unroll
                for (int c = 0; c < 9; ++c) { const float s = sv[c * 1024 + wave * 128 + k]; ax[c] += s * wv.x; ay[c] += s * wv.y; }
            }
#pragma unroll
            for (int c = 0; c < 9; ++c) { part[(wave * 9 + c) * 128 + 2 * lane] = ax[c]; part[(wave * 9 + c) * 128 + 2 * lane + 1] = ay[c]; }
            __syncthreads();
            for (int e = tid; e < 1152; e += 512) {
                const int c = e >> 7, cc = e & 127; float s = 0.f;
#pragma unroll
                for (int w = 0; w < 8; ++w) s += part[(w * 9 + c) * 128 + cc];
                X.mod()[((size_t)(layer * 9 + c)) * 9216 + chunk * 128 + cc] = s + X.in[7][layer * 9216 + chunk * 128 + cc];
            }
            __syncthreads();
        }
    }
    __syncthreads();
    P0(3) {
        LAS float* tab = (LAS float*)lds;
        for (int m = tid; m < 4096; m += 512) tab[m] = cospif((float)m * (1.0f / 2048.0f));
        __syncthreads();
        for (int k = bid; k < 4096; k += G) {
#pragma unroll
            for (int i = 0; i < 2; ++i) {
                const int c8 = (tid + 512 * i) * 8;
                float x[8];
#pragma unroll
                for (int j = 0; j < 8; ++j) { const int col = c8 + j;
                    if (col < 4096) x[j] = tab[(k * col) & 4095] * (1.0f / 512.0f);
                    else x[j] = -tab[(k * (col - 4096) - 1024) & 4095] * (1.0f / 512.0f); }
                u32x4 w; w.x = cvt_pk_bf16(x[0], x[1]); w.y = cvt_pk_bf16(x[2], x[3]); w.z = cvt_pk_bf16(x[4], x[5]); w.w = cvt_pk_bf16(x[6], x[7]);
                *(u32x4*)(X.dl() + (size_t)k * 8192 + c8) = w;
            }
        }
        for (int k = bid; k < 256; k += G) {
            if (tid < 64) {
                const int c8 = tid * 8; float x[8];
#pragma unroll
                for (int j = 0; j < 8; ++j) { const int col = c8 + j;
                    if (col < 256) x[j] = tab[((k * col) & 255) * 16] * (1.0f / 128.0f);
                    else x[j] = -tab[((((k * (col - 256)) & 255) * 16) - 1024) & 4095] * (1.0f / 128.0f); }
                u32x4 w; w.x = cvt_pk_bf16(x[0], x[1]); w.y = cvt_pk_bf16(x[2], x[3]); w.z = cvt_pk_bf16(x[4], x[5]); w.w = cvt_pk_bf16(x[6], x[7]);
                *(u32x4*)(X.dc() + (size_t)k * 512 + c8) = w;
            }
        }
    }
    __syncthreads();
    P0(4) for (int u = bid; u < 128; u += G) {
        const float dt = expf(X.in[15][u]);
        for (int e = tid; e < 2048; e += 512) {
            const int col = e >> 4, ch = e & 15, blk = col >> 5, r = col & 31, p = r + 32 * (blk >> 1), ri = blk & 1;
            const float lr = X.in[13][u * 64 + p], li = X.in[14][u * 64 + p];
            const float ea = expf(lr * dt), ar = ea * cosf(li * dt), ai = ea * sinf(li * dt);
            const float den = lr * lr + li * li, nr = ar - 1.0f;
            const float cr = (nr * lr + ai * li) / den, ci = (ai * lr - nr * li) / den;
            const float br = X.in[16][((size_t)u * 64 + p) * 16 + ch], bi = X.in[17][((size_t)u * 64 + p) * 16 + ch];
            const float val = ri ? (cr * bi + ci * br) : (cr * br - ci * bi);
            X.s5b()[((size_t)u * 128 + col) * 16 + ch] = f2bf(val);
        }
        for (int e = tid; e < 2048; e += 512) {
            const int hp = e >> 7, kk = e & 127, r = kk >> 2, blk = kk & 3, p = r + 32 * (blk >> 1), ri = blk & 1;
            const float val = ri ? -X.in[19][((size_t)u * 16 + hp) * 64 + p] : X.in[18][((size_t)u * 16 + hp) * 64 + p];
            X.s5c()[((size_t)u * 16 + hp) * 128 + kk] = f2bf(val);
        }
        if (tid < 64) {
            const float lr = X.in[13][u * 64 + tid], li = X.in[14][u * 64 + tid];
            const float ea = expf(lr * dt);
            f32x2v a; a.x = ea * cosf(li * dt); a.y = ea * sinf(li * dt);
            X.s5a()[u * 64 + tid] = a;
        }
    }
    P0(5) {
        const size_t gt = (size_t)bid * 512 + tid, gs = (size_t)G * 512;
        for (size_t i = gt; i < (size_t)MTOT * 256; i += gs) {
            const int row = (int)(i >> 8), c4 = (int)(i & 255) * 4;
            f32x4 x;
            if (row < MCTX) x = *(const f32x4*)(X.in[0] + (size_t)row * D + c4);
            else {
                x = *(const f32x4*)(X.in[1] + (size_t)(row - MCTX) * D + c4);
                const int t = (row - MCTX) & 4095;
                const float pos = (float)((c4 < 512) ? (t >> 6) : (t & 63));
#pragma unroll
                for (int j = 0; j < 4; ++j) {
                    const int cc = (c4 + j) & 511, ii = cc & 255;
                    const float omega = 1.0f / powf(10000.0f, (float)ii * (1.0f / 256.0f));
                    const float ang = pos * omega;
                    x[j] += (cc < 256) ? sinf(ang) : cosf(ang);
                }
            }
            *(f32x4*)(X.v() + (size_t)row * D + c4) = x;
        }
        for (size_t i = gt; i < (size_t)4 * 4 * 128 * 128; i += gs) X.wsgu()[i] = f2bf(X.in[26][i]);
    }
}

__device__ __forceinline__ void phase_lnmod(const Ctx& Xin, int layer, int sub, bool do_ln, const float* lnG, const float* lnB) {
    OPAQUE_CTX(X, Xin);
    const int tid_ = otid(), lane = tid_ & 63, gw = blockIdx.x * 8 + (tid_ >> 6), nw = gridDim.x * 8;
    const float* modL = X.mod() + (size_t)layer * 9 * 9216;
    for (int row = gw; row < MTOT; row += nw) {
        const float* vr = X.v() + (size_t)row * D;
        f32x4 x[4];
#pragma unroll
        for (int i = 0; i < 4; ++i) x[i] = *(const f32x4*)(vr + i * 256 + lane * 4);
        float mean = 0.f, rstd = 1.f;
        if (do_ln) {
            float s = 0.f;
#pragma unroll
            for (int i = 0; i < 4; ++i) s += (x[i][0] + x[i][1]) + (x[i][2] + x[i][3]);
            mean = wave_sum(s) * (1.0f / 1024.0f);
            float q = 0.f;
#pragma unroll
            for (int i = 0; i < 4; ++i) { const f32x4 d = x[i] - mean; q += (d[0] * d[0] + d[1] * d[1]) + (d[2] * d[2] + d[3] * d[3]); }
            rstd = rsqrtf(wave_sum(q) * (1.0f / 1024.0f) + LN_EPS);
        }
        if (lane == 0) { f32x2v st; st.x = mean; st.y = rstd; X.stats()[row] = st; }
        const int cond = (row < MCTX) ? 8 : ((row - MCTX) >> 12);
        const float* sh = modL + (size_t)cond * 9216 + (sub * 3 + 0) * 1024;
        const float* sc = modL + (size_t)cond * 9216 + (sub * 3 + 1) * 1024;
#pragma unroll
        for (int i = 0; i < 4; ++i) {
            const int col = i * 256 + lane * 4;
            f32x4 xv = x[i];
            if (do_ln) xv = (xv - mean) * rstd * *(const f32x4*)(lnG + col) + *(const f32x4*)(lnB + col);
            const f32x4 hv = xv * (1.0f + *(const f32x4*)(sc + col)) + *(const f32x4*)(sh + col);
            u32x2 w; w.x = cvt_pk_bf16(hv[0], hv[1]); w.y = cvt_pk_bf16(hv[2], hv[3]);
            *(u32x2*)(X.h() + (size_t)row * D + col) = w;
        }
    }
}

__device__ __forceinline__ void phase_final_ln(const Ctx& Xin, const float* lnG, const float* lnB) {
    OPAQUE_CTX(X, Xin);
    const int tid_ = otid(), lane = tid_ & 63, gw = blockIdx.x * 8 + (tid_ >> 6), nw = gridDim.x * 8;
    for (int row = gw; row < MTOT; row += nw) {
        float* vr = X.v() + (size_t)row * D;
        f32x4 x[4];
#pragma unroll
        for (int i = 0; i < 4; ++i) x[i] = *(const f32x4*)(vr + i * 256 + lane * 4);
        float s = 0.f;
#pragma unroll
        for (int i = 0; i < 4; ++i) s += (x[i][0] + x[i][1]) + (x[i][2] + x[i][3]);
        const float mean = wave_sum(s) * (1.0f / 1024.0f);
        float q = 0.f;
#pragma unroll
        for (int i = 0; i < 4; ++i) { const f32x4 d = x[i] - mean; q += (d[0] * d[0] + d[1] * d[1]) + (d[2] * d[2] + d[3] * d[3]); }
        const float rstd = rsqrtf(wave_sum(q) * (1.0f / 1024.0f) + LN_EPS);
#pragma unroll
        for (int i = 0; i < 4; ++i) {
            const int col = i * 256 + lane * 4;
            *(f32x4*)(vr + col) = (x[i] - mean) * rstd * *(const f32x4*)(lnG + col) + *(const f32x4*)(lnB + col);
        }
    }
}

struct EpiSwiGLU {
    static constexpr bool PERM = true, AFTER_DRAIN = false;
    bf16_t* act;
    __device__ __forceinline__ void operator()(const f32x4 (&acc)[2][2][4][2], const Unit& u, int wr, int wc, int fr, int fq) const {
        const int row0 = u.pm * 256 + wr * 64 + fr, colo = u.pn * 128 + wc * 32 + 8 * fq;
#pragma unroll
        for (int ai = 0; ai < 2; ++ai)
#pragma unroll
            for (int m = 0; m < 4; ++m) {
                const int row = row0 + ai * 128 + m * 16;
                float o[8];
#pragma unroll
                for (int n = 0; n < 2; ++n)
#pragma unroll
                    for (int j = 0; j < 4; ++j) o[n * 4 + j] = siluf_(acc[ai][1][m][n][j]) * acc[ai][0][m][n][j];
                u32x4 w; w.x = cvt_pk_bf16(o[0], o[1]); w.y = cvt_pk_bf16(o[2], o[3]); w.z = cvt_pk_bf16(o[4], o[5]); w.w = cvt_pk_bf16(o[6], o[7]);
                *(u32x4*)(act + (size_t)row * DFF + colo) = w;
            }
    }
};

struct EpiRes {
    static constexpr bool PERM = false, AFTER_DRAIN = false;
    float* v; const f32x2v* stats; const float* lnG; const float* lnB; const float* modL; int gate_k; float coef; int do_ln;
    __device__ __forceinline__ void operator()(const f32x4 (&acc)[2][2][4][2], const Unit& u, int wr, int wc, int fr, int fq) const {
        const int cond = (u.pm < 16) ? 8 : ((u.pm - 16) >> 4);
        const float* gate = modL + (size_t)cond * 9216 + gate_k * 1024;
        const int row0 = u.pm * 256 + wr * 64 + fr, col0 = u.pn * 256 + wc * 32 + 4 * fq;
#pragma unroll
        for (int bj = 0; bj < 2; ++bj)
#pragma unroll
            for (int n = 0; n < 2; ++n) {
                const int col = col0 + bj * 128 + n * 16;
                const f32x4 g4 = *(const f32x4*)(gate + col) * coef;
                f32x4 G4 = {1.f, 1.f, 1.f, 1.f}, B4 = {0.f, 0.f, 0.f, 0.f};
                if (do_ln) { G4 = *(const f32x4*)(lnG + col); B4 = *(const f32x4*)(lnB + col); }
#pragma unroll
                for (int ai = 0; ai < 2; ++ai)
#pragma unroll
                    for (int m = 0; m < 4; ++m) {
                        const int row = row0 + ai * 128 + m * 16;
                        float* p = v + (size_t)row * D + col;
                        f32x4 x = *(const f32x4*)p;
                        if (do_ln) { const f32x2v st = stats[row]; x = (x - st.x) * st.y * G4 + B4; }
                        *(f32x4*)p = ALPHA * x + g4 * acc[ai][bj][m][n];
                    }
            }
    }
};

struct EpiMixIn {
    static constexpr bool PERM = true, AFTER_DRAIN = false;
    bf16_t *z, *ptl, *ptc;
    __device__ __forceinline__ void operator()(const f32x4 (&acc)[2][2][4][2], const Unit& u, int wr, int wc, int fr, int fq) const {
        const int row0 = u.pm * 256 + wr * 64 + fr;
        if (u.pn == 1 || u.pn == 2) {
            const int cs = u.pn - 1;
#pragma unroll
            for (int ai = 0; ai < 2; ++ai)
#pragma unroll
                for (int m = 0; m < 4; ++m) {
                    const int row = row0 + ai * 128 + m * 16;
                    bf16_t* base; size_t stride;
                    if (row < MCTX) { const int b = row >> 8, n = row & 255; base = ptc + ((size_t)(b * 256)) * 512 + cs * 256 + n; stride = 512; }
                    else { const int r2 = row - MCTX, b = r2 >> 12, n = r2 & 4095; base = ptl + ((size_t)(b * 256)) * 8192 + cs * 4096 + n; stride = 8192; }
#pragma unroll
                    for (int bj = 0; bj < 2; ++bj)
#pragma unroll
                        for (int n = 0; n < 2; ++n)
#pragma unroll
                            for (int j = 0; j < 4; ++j) { const int hd = bj * 128 + wc * 32 + 8 * fq + 4 * n + j; base[(size_t)hd * stride] = f2bf(acc[ai][bj][m][n][j]); }
                    asm volatile("" ::: "memory");
                }
        } else {
            const int zc0 = (u.pn == 0) ? 0 : (u.pn == 3 ? 256 : (u.pn == 4 ? 512 : 768));
#pragma unroll
            for (int ai = 0; ai < 2; ++ai)
#pragma unroll
                for (int m = 0; m < 4; ++m) {
                    const int row = row0 + ai * 128 + m * 16;
#pragma unroll
                    for (int bj = 0; bj < 2; ++bj) {
                        const f32x4 a0 = acc[ai][bj][m][0], a1 = acc[ai][bj][m][1];
                        u32x4 w; w.x = cvt_pk_bf16(a0[0], a0[1]); w.y = cvt_pk_bf16(a0[2], a0[3]); w.z = cvt_pk_bf16(a1[0], a1[1]); w.w = cvt_pk_bf16(a1[2], a1[3]);
                        *(u32x4*)(z + (size_t)row * D + zc0 + bj * 128 + wc * 32 + 8 * fq) = w;
                    }
                    asm volatile("" ::: "memory");
                }
        }
    }
};

struct EpiDft {
    static constexpr bool PERM = true, AFTER_DRAIN = false;
    bf16_t* ycat; int rowbase, seqlen;
    __device__ __forceinline__ void operator()(const f32x4 (&acc)[2][2][4][2], const Unit& u, int wr, int wc, int fr, int fq) const {
        const int row0 = rowbase + u.pn * seqlen + u.pm * 256 + wr * 64 + fr;
#pragma unroll
        for (int ai = 0; ai < 2; ++ai)
#pragma unroll
            for (int m = 0; m < 4; ++m) {
                const int row = row0 + ai * 128 + m * 16;
#pragma unroll
                for (int bj = 0; bj < 2; ++bj) {
                    const f32x4 a0 = acc[ai][bj][m][0], a1 = acc[ai][bj][m][1];
                    u32x4 w; w.x = cvt_pk_bf16(a0[0], a0[1]); w.y = cvt_pk_bf16(a0[2], a0[3]); w.z = cvt_pk_bf16(a1[0], a1[1]); w.w = cvt_pk_bf16(a1[2], a1[3]);
                    *(u32x4*)(ycat + (size_t)row * D + 256 + bj * 128 + wc * 32 + 8 * fq) = w;
                }
            }
    }
};

struct EpiGlu {
    static constexpr bool PERM = true, AFTER_DRAIN = false;
    const bf16_t* ya; bf16_t* ycat; const float* bias;
    __device__ __forceinline__ void operator()(const f32x4 (&acc)[2][2][4][2], const Unit& u, int wr, int wc, int fr, int fq) const {
        const int row0 = u.pm * 256 + wr * 64 + fr;
#pragma unroll
        for (int bj = 0; bj < 2; ++bj) {
            const int lc = bj * 128 + wc * 32 + 8 * fq;
            const f32x4 b0 = *(const f32x4*)(bias + lc), b1 = *(const f32x4*)(bias + lc + 4);
#pragma unroll
            for (int ai = 0; ai < 2; ++ai)
#pragma unroll
                for (int m = 0; m < 4; ++m) {
                    const int row = row0 + ai * 128 + m * 16;
                    const u32x4 yv = *(const u32x4*)(ya + (size_t)row * 256 + lc);
                    const f32x4 a0 = acc[ai][bj][m][0] + b0, a1 = acc[ai][bj][m][1] + b1;
                    float o[8];
                    o[0] = bflo(yv.x) * sigmoidf_(a0[0]); o[1] = bfhi(yv.x) * sigmoidf_(a0[1]); o[2] = bflo(yv.y) * sigmoidf_(a0[2]); o[3] = bfhi(yv.y) * sigmoidf_(a0[3]);
                    o[4] = bflo(yv.z) * sigmoidf_(a1[0]); o[5] = bfhi(yv.z) * sigmoidf_(a1[1]); o[6] = bflo(yv.w) * sigmoidf_(a1[2]); o[7] = bfhi(yv.w) * sigmoidf_(a1[3]);
                    u32x4 w; w.x = cvt_pk_bf16(o[0], o[1]); w.y = cvt_pk_bf16(o[2], o[3]); w.z = cvt_pk_bf16(o[4], o[5]); w.w = cvt_pk_bf16(o[6], o[7]);
                    *(u32x4*)(ycat + (size_t)row * D + lc) = w;
                    asm volatile("" ::: "memory");
                }
        }
    }
};

__device__ __forceinline__ void s5_unit(const Ctx& Xin, LAS unsigned char* hl, int layer, int dir, int g, int rowA, int rowB, int L, int bA, int bB, bool latent) {
    OPAQUE_CTX(X, Xin);
    const int lane = otid() & 63, r = lane & 31, half = lane >> 5;
    const int ldg = (layer * 2 + dir) * 16 + g;
    bf16x8 bfr[4], cfr[8];
#pragma unroll
    for (int blk = 0; blk < 4; ++blk) bfr[blk] = *(const bf16x8*)(X.s5b() + ((size_t)(ldg * 128 + blk * 32 + r)) * 16 + 8 * half);
#pragma unroll
    for (int s = 0; s < 8; ++s) {
        bf16x8 c = {0, 0, 0, 0, 0, 0, 0, 0};
        if (r < 16) c = *(const bf16x8*)(X.s5c() + ((size_t)(ldg * 16 + r)) * 128 + 16 * s + 8 * half);
        cfr[s] = c;
    }
    const f32x2v a0 = X.s5a()[ldg * 64 + r], a1 = X.s5a()[ldg * 64 + r + 32];
    float s0r = 0.f, s0i = 0.f, s1r = 0.f, s1i = 0.f;
    const int myb = half ? bB : bA, myrow = half ? rowB : rowA;
    if (latent) {
        const size_t idx = ((size_t)((myb * 4 + layer) * 2 + dir) * 16 + g) * 64;
        s0r = X.in[3][idx + r]; s0i = X.in[4][idx + r]; s1r = X.in[3][idx + r + 32]; s1i = X.in[4][idx + r + 32];
    }
    const int hs = (r >> 2) & 1, jA = (r & 3) + 4 * (r >> 3);
    const bf16_t* ubase = X.z() + (size_t)((hs ? rowB : rowA) + jA) * D + g * 16 + 8 * half;
    bf16_t* yout = dir ? X.yb() : X.yf();
    const int ngrp = L >> 4;
    bf16x8 afr = *(const bf16x8*)(ubase + (size_t)(dir ? (L - 16) : 0) * D);
    for (int it = 0; it < ngrp; ++it) {
        const int t0 = dir ? (L - 16 * (it + 1)) : (16 * it);
        bf16x8 anext = afr;
        if (it + 1 < ngrp) anext = *(const bf16x8*)(ubase + (size_t)(dir ? (t0 - 16) : (t0 + 16)) * D);
        const f32x16 zero16 = {0.f, 0.f, 0.f, 0.f, 0.f, 0.f, 0.f, 0.f, 0.f, 0.f, 0.f, 0.f, 0.f, 0.f, 0.f, 0.f};
        const f32x16 bu0 = __builtin_amdgcn_mfma_f32_32x32x16_bf16(afr, bfr[0], zero16, 0, 0, 0);
        const f32x16 bu1 = __builtin_amdgcn_mfma_f32_32x32x16_bf16(afr, bfr[1], zero16, 0, 0, 0);
        const f32x16 bu2 = __builtin_amdgcn_mfma_f32_32x32x16_bf16(afr, bfr[2], zero16, 0, 0, 0);
        const f32x16 bu3 = __builtin_amdgcn_mfma_f32_32x32x16_bf16(afr, bfr[3], zero16, 0, 0, 0);
#pragma unroll
        for (int jj = 0; jj < 16; ++jj) {
            const int j = dir ? (15 - jj) : jj;
            const float n0r = a0.x * s0r - a0.y * s0i + bu0[j], n0i = a0.x * s0i + a0.y * s0r + bu1[j];
            const float n1r = a1.x * s1r - a1.y * s1i + bu2[j], n1i = a1.x * s1i + a1.y * s1r + bu3[j];
            s0r = n0r; s0i = n0i; s1r = n1r; s1i = n1i;
            const int rho = (j & 3) + 8 * (j >> 2) + 4 * half;
            u32x2 w; w.x = cvt_pk_bf16(s0r, s0i); w.y = cvt_pk_bf16(s1r, s1i);
            *(LAS u32x2*)(hl + rho * 272 + r * 8) = w;
        }
        asm volatile("s_waitcnt lgkmcnt(0)" ::: "memory");
        f32x16 y = zero16;
#pragma unroll
        for (int s = 0; s < 8; ++s) {
            const bf16x8 ha = *(const LAS bf16x8*)(hl + r * 272 + (16 * s + 8 * half) * 2);
            y = __builtin_amdgcn_mfma_f32_32x32x16_bf16(ha, cfr[s], y, 0, 0, 0);
        }
        asm volatile("s_waitcnt lgkmcnt(0)" ::: "memory");
        if (r < 16) {
#pragma unroll
            for (int j = 0; j < 16; ++j) yout[(size_t)(myrow + t0 + j) * 256 + g * 16 + r] = f2bf(y[j]);
        }
        afr = anext;
    }
    if (!latent) {
        const size_t idx = ((size_t)((myb * 4 + layer) * 2 + dir) * 16 + g) * 64;
        X.out[OUT_RE + idx + r] = s0r; X.out[OUT_IM + idx + r] = s0i; X.out[OUT_RE + idx + r + 32] = s1r; X.out[OUT_IM + idx + r + 32] = s1i;
    }
}

__device__ __forceinline__ void sgu_prep_item(const Ctx& Xin, int witem) {
    OPAQUE_CTX(X, Xin);
    const int lane = otid() & 63, g = witem & 3, row = (witem >> 2) * 64 + lane;
    const bf16_t* zp = X.z() + (size_t)row * D + 768 + g * 64;
    float x[64];
#pragma unroll
    for (int q = 0; q < 8; ++q) {
        const u32x4 w = *(const u32x4*)(zp + q * 8);
        x[q * 8 + 0] = geluf_(bflo(w.x)); x[q * 8 + 1] = geluf_(bfhi(w.x)); x[q * 8 + 2] = geluf_(bflo(w.y)); x[q * 8 + 3] = geluf_(bfhi(w.y));
        x[q * 8 + 4] = geluf_(bflo(w.z)); x[q * 8 + 5] = geluf_(bfhi(w.z)); x[q * 8 + 6] = geluf_(bflo(w.w)); x[q * 8 + 7] = geluf_(bfhi(w.w));
    }
    float s = 0.f;
#pragma unroll
    for (int c = 0; c < 64; ++c) s += x[c];
    const float mean = s * (1.0f / 64.0f);
    float q2 = 0.f;
#pragma unroll
    for (int c = 0; c < 64; ++c) { const float d = x[c] - mean; q2 += d * d; }
    const float rstd = rsqrtf(q2 * (1.0f / 64.0f) + LN_EPS);
    bf16_t* dst = X.vnt() + ((size_t)((row >> 7) * 4 + g)) * 64 * 128 + (row & 127);
#pragma unroll
    for (int c = 0; c < 64; ++c) dst[c * 128] = f2bf((x[c] - mean) * rstd);
}

__device__ __forceinline__ void phase_l7(const Ctx& Xin, int layer) {
    OPAQUE_CTX(X, Xin);
    const int tid = otid(), lane = tid & 63, wave = tid >> 6, G = gridDim.x;
    {
        const float* dsk = X.in[20] + layer * 256;
        const size_t gt = (size_t)blockIdx.x * 512 + tid, gs = (size_t)G * 512;
        for (size_t i = gt; i < (size_t)MTOT * 32; i += gs) {
            const int row = (int)(i >> 5), c8 = (int)(i & 31) * 8;
            const u32x4 uw = *(const u32x4*)(X.z() + (size_t)row * D + c8);
            const u32x4 fw = *(const u32x4*)(X.yf() + (size_t)row * 256 + c8);
            const u32x4 bw = *(const u32x4*)(X.yb() + (size_t)row * 256 + c8);
            const f32x4 d0 = *(const f32x4*)(dsk + c8), d1 = *(const f32x4*)(dsk + c8 + 4);
            float o[8];
            o[0] = geluf_(bflo(uw.x) * d0[0] + bflo(fw.x) + bflo(bw.x)); o[1] = geluf_(bfhi(uw.x) * d0[1] + bfhi(fw.x) + bfhi(bw.x));
            o[2] = geluf_(bflo(uw.y) * d0[2] + bflo(fw.y) + bflo(bw.y)); o[3] = geluf_(bfhi(uw.y) * d0[3] + bfhi(fw.y) + bfhi(bw.y));
            o[4] = geluf_(bflo(uw.z) * d1[0] + bflo(fw.z) + bflo(bw.z)); o[5] = geluf_(bfhi(uw.z) * d1[1] + bfhi(fw.z) + bfhi(bw.z));
            o[6] = geluf_(bflo(uw.w) * d1[2] + bflo(fw.w) + bflo(bw.w)); o[7] = geluf_(bfhi(uw.w) * d1[3] + bfhi(fw.w) + bfhi(bw.w));
            u32x4 w; w.x = cvt_pk_bf16(o[0], o[1]); w.y = cvt_pk_bf16(o[2], o[3]); w.z = cvt_pk_bf16(o[4], o[5]); w.w = cvt_pk_bf16(o[6], o[7]);
            *(u32x4*)(X.ya() + (size_t)row * 256 + c8) = w;
        }
    }
    {
        const int r = lane & 31, half = lane >> 5, tr = wave >> 1, tc = wave & 1;
        for (int unit = blockIdx.x; unit < 1152; unit += G) {
            const int chunk = unit >> 2, g = unit & 3;
            const bf16_t* Ap = X.wsgu() + ((size_t)((layer * 4 + g) * 128 + tr * 32 + r)) * 128 + 8 * half;
            const bf16_t* Bp = X.vnt() + ((size_t)((chunk * 4 + g) * 64 + tc * 32 + r)) * 128 + 8 * half;
            f32x16 acc = {0.f, 0.f, 0.f, 0.f, 0.f, 0.f, 0.f, 0.f, 0.f, 0.f, 0.f, 0.f, 0.f, 0.f, 0.f, 0.f};
#pragma unroll
            for (int s = 0; s < 8; ++s) {
                const bf16x8 a = *(const bf16x8*)(Ap + 16 * s), b = *(const bf16x8*)(Bp + 16 * s);
                acc = __builtin_amdgcn_mfma_f32_32x32x16_bf16(a, b, acc, 0, 0, 0);
            }
            const int c = tc * 32 + r;
            const float* sb = X.in[27] + (layer * 4 + g) * 128;
#pragma unroll
            for (int j = 0; j < 16; ++j) {
                const int t = tr * 32 + (j & 3) + 8 * (j >> 2) + 4 * half, row = chunk * 128 + t;
                const float sv = acc[j] + sb[t];
                const float uu = geluf_(bf2f(X.z()[(size_t)row * D + 512 + g * 64 + c]));
                X.ycat()[(size_t)row * D + 768 + g * 64 + c] = f2bf(uu * sv);
            }
        }
    }
}

__device__ __forceinline__ void phase_finalize(const Ctx& Xin, int layer) {
    OPAQUE_CTX(X, Xin);
    const int tid_ = otid(), lane = tid_ & 63, gw = blockIdx.x * 8 + (tid_ >> 6), nw = gridDim.x * 8, c4 = 4 * lane;
    const float* png = X.in[12] + layer * 1024;
    const f32x4 ps = *(const f32x4*)(X.in[25] + layer * 256 + c4);
    for (int row = gw; row < MTOT; row += nw) {
        int sb, n, t;
        if (row < MCTX) { sb = row & ~255; n = 256; t = row & 255; } else { const int r2 = row - MCTX; sb = MCTX + (r2 & ~4095); n = 4096; t = r2 & 4095; }
        f32x4 y[4];
        { const u32x2 w = *(const u32x2*)(X.ycat() + (size_t)row * D + c4); y[0] = (f32x4){bflo(w.x), bfhi(w.x), bflo(w.y), bfhi(w.y)}; }
        { const u32x2 w = *(const u32x2*)(X.ycat() + (size_t)row * D + 256 + c4); y[1] = (f32x4){bflo(w.x), bfhi(w.x), bflo(w.y), bfhi(w.y)}; }
        { const u32x2 w = *(const u32x2*)(X.ycat() + (size_t)row * D + 768 + c4); y[3] = (f32x4){bflo(w.x), bfhi(w.x), bflo(w.y), bfhi(w.y)}; }
        {
            const int hw = 1 << (lane >> 4);
            const int lo = (t - hw) < 0 ? 0 : (t - hw), hi = (t + hw) > n ? n : (t + hw);
            f32x4 sum = {0.f, 0.f, 0.f, 0.f};
            for (int s = lo; s < hi; ++s) { const u32x2 w = *(const u32x2*)(X.z() + (size_t)(sb + s) * D + 256 + c4); sum += (f32x4){bflo(w.x), bfhi(w.x), bflo(w.y), bfhi(w.y)}; }
            const u32x2 w = *(const u32x2*)(X.z() + (size_t)row * D + 256 + c4);
            const f32x4 qt = {bflo(w.x), bfhi(w.x), bflo(w.y), bfhi(w.y)};
            y[2] = (sum * (1.0f / (float)(hi - lo)) - qt) * ps;
        }
#pragma unroll
        for (int gq = 0; gq < 4; ++gq) {
            const f32x4 v = y[gq];
            const float ss = wave_sum((v[0] * v[0] + v[1] * v[1]) + (v[2] * v[2] + v[3] * v[3]));
            const float sc = rsqrtf(ss * (1.0f / 256.0f) + LN_EPS);
            const f32x4 o = v * sc * *(const f32x4*)(png + gq * 256 + c4);
            u32x2 w; w.x = cvt_pk_bf16(o[0], o[1]); w.y = cvt_pk_bf16(o[2], o[3]);
            *(u32x2*)(X.h() + (size_t)row * D + gq * 256 + c4) = w;
        }
    }
}

__global__ void __launch_bounds__(512, 2) fwd_megakernel(Args a) {
    extern __shared__ __attribute__((aligned(16))) unsigned char lds_raw[];
    LAS unsigned char* lds = (LAS unsigned char*)lds_raw;
    cg::grid_group grid = cg::this_grid();
    Ctx X0; X0.out = a.out; X0.ws = a.ws;
    const int G = gridDim.x, bid = blockIdx.x;

#ifndef PHMASK
#define PHMASK 0xFFFF
#endif
#define PH(k) if ((PHMASK >> (k)) & 1)
    PH(0) phase0(X0, lds);
    grid.sync();

    for (int sl = 0; sl < 12; ++sl) {
        const int layer = sl / 3, sub = sl % 3;
        const int do_ln = sl > 0;
        OPAQUE_CTX(X, X0);
        const float* pG = X.in[28] + (size_t)(do_ln ? sl - 1 : 0) * D;
        const float* pB = X.in[29] + (size_t)(do_ln ? sl - 1 : 0) * D;
        const float* modL = X.mod() + (size_t)layer * 9 * 9216;
        PH(1) phase_lnmod(X0, layer, sub, do_ln, pG, pB);
        grid.sync();
        if (sub != 1) {
            const int li = layer * 2 + (sub >> 1);
            PH(2) {
                pg8::Gemm g{X.h(), X.wfi() + (size_t)li * NFI * D, MTOT, NFI, D}; pg8::StaticOrder S; S.init(MTOT, NFI, G, bid);
                EpiSwiGLU E{X.act()};
                pg8::gemm_phase<EpiSwiGLU, pg8::StaticOrder>(lds, g, S, E, nullptr);
            }
            grid.sync();
            PH(3) {
                pg8::Gemm g{X.act(), X.wfo() + (size_t)li * D * DFF, MTOT, D, DFF}; pg8::StaticOrder S; S.init(MTOT, D, G, bid);
                EpiRes E{X.v(), X.stats(), pG, pB, modL, sub * 3 + 2, 0.5f, do_ln};
                pg8::gemm_phase<EpiRes, pg8::StaticOrder>(lds, g, S, E, nullptr);
            }
            grid.sync();
        } else {
            PH(4) {
                pg8::Gemm g{X.h(), X.wmi() + (size_t)layer * NMI * D, MTOT, NMI, D}; pg8::StaticOrder S; S.init(MTOT, NMI, G, bid);
                EpiMixIn E{X.z(), X.ptl(), X.ptc()};
                pg8::gemm_phase<EpiMixIn, pg8::StaticOrder>(lds, g, S, E, nullptr);
            }
            grid.sync();
            {
                const int nd = G >> 1, ns = G - nd;
                if (bid < nd) { PH(5) {
#pragma nounroll
                    for (int pass = 0; pass < 2; ++pass) {
                        pg8::Gemm g; pg8::StaticOrder S; EpiDft E;
                        if (pass == 0) { g = pg8::Gemm{X.dl(), X.ptl(), 4096, 2048, 8192}; S.init(4096, 2048, nd, bid); E = EpiDft{X.ycat(), MCTX, 4096}; }
                        else { g = pg8::Gemm{X.dc(), X.ptc(), 256, 4096, 512}; S.init(256, 4096, nd, bid); E = EpiDft{X.ycat(), 0, 256}; }
                        pg8::gemm_phase<EpiDft, pg8::StaticOrder>(lds, g, S, E, nullptr);
                    }
                } } else {
                    const int c = bid - nd, wave = otid() >> 6;
                    LAS unsigned char* hl = lds + wave * 8704;
                    PH(6) if (wave == 0) {
                        for (int u = c; u < 128; u += ns) { const int g = u & 15, dir = (u >> 4) & 1, bp = u >> 5;
                            s5_unit(X0, hl, layer, dir, g, MCTX + bp * 4096, MCTX + (bp + 4) * 4096, 4096, bp, bp + 4, true); }
                    } else if (wave < 3) {
                        for (int u = c * 2 + (wave - 1); u < 256; u += ns * 2) { const int g = u & 15, dir = (u >> 4) & 1, bp = u >> 5;
                            s5_unit(X0, hl, layer, dir, g, bp * 256, (bp + 8) * 256, 256, bp, bp + 8, false); }
                    } else {
                        for (int w = c * 5 + (wave - 3); w < 2304; w += ns * 5) sgu_prep_item(X0, w);
                    }
                }
            }
            grid.sync();
            PH(7) phase_l7(X0, layer);
            grid.sync();
            PH(8) {
                pg8::Gemm g{X.ya(), X.wglu() + (size_t)layer * 65536, MTOT, 256, 256 + (G >> 20)}; pg8::StaticOrder S; S.init(MTOT, 256, G, bid);
                EpiGlu E{X.ya(), X.ycat(), X.in[22] + layer * 256};
                pg8::gemm_phase<EpiGlu, pg8::StaticOrder>(lds, g, S, E, nullptr);
            }
            grid.sync();
            PH(9) phase_finalize(X0, layer);
            grid.sync();
            PH(10) {
                pg8::Gemm g{X.h(), X.wmo() + (size_t)layer * D * D, MTOT, D, D}; pg8::StaticOrder S; S.init(MTOT, D, G, bid);
                EpiRes E{X.v(), X.stats(), pG, pB, modL, 5, 1.0f, do_ln};
                pg8::gemm_phase<EpiRes, pg8::StaticOrder>(lds, g, S, E, nullptr);
            }
            grid.sync();
        }
    }
    PH(11) phase_final_ln(X0, X0.in[28] + (size_t)11 * D, X0.in[29] + (size_t)11 * D);
}

extern "C" void kernel_launch(void* const* d_in, const int* in_sizes, int n_in, void* d_out, int out_size,
                              void* d_ws, size_t ws_size, hipStream_t stream) {
    static int grid_blocks = 0;
    if (!grid_blocks) {
        if (n_in != 30 || out_size != OUT_TOTAL || ws_size < WS_END) {
            fprintf(stderr, "kernel_launch: unexpected shapes: n_in %d out %d (want %d) ws %zu (need %zu)\n", n_in, out_size, OUT_TOTAL, ws_size, (size_t)WS_END);
            grid_blocks = -1; return;
        }
        int dev = 0, cus = 0, per_cu = 0;
        if (hipGetDevice(&dev) != hipSuccess || hipDeviceGetAttribute(&cus, hipDeviceAttributeMultiprocessorCount, dev) != hipSuccess) { grid_blocks = -1; return; }
        if (hipFuncSetAttribute((const void*)fwd_megakernel, hipFuncAttributeMaxDynamicSharedMemorySize, LDS_BYTES) != hipSuccess) { fprintf(stderr, "hipFuncSetAttribute failed\n"); grid_blocks = -1; return; }
        if (hipOccupancyMaxActiveBlocksPerMultiprocessor(&per_cu, (const void*)fwd_megakernel, 512, LDS_BYTES) != hipSuccess || per_cu < 1) {
            fprintf(stderr, "kernel_launch: occupancy query says %d blocks per CU\n", per_cu); (void)hipGetLastError(); }
        grid_blocks = cus;
    }
    if (grid_blocks < 0) return;
    Args a{};
    for (int i = 0; i < 30; ++i) a.in[i] = (const float*)d_in[i];
    a.out = (float*)d_out; a.ws = (unsigned char*)d_ws;
    void* args[] = {&a};
    hipError_t e = hipLaunchCooperativeKernel((void*)fwd_megakernel, dim3(grid_blocks), dim3(512), args, LDS_BYTES, stream);
    if (e != hipSuccess) fprintf(stderr, "cooperative launch failed: %s (grid %d)\n", hipGetErrorString(e), grid_blocks);
}
```

```cpp
#include <hip/hip_runtime.h>
#include <hip/hip_cooperative_groups.h>
#include <cstdio>
namespace cg = cooperative_groups;
namespace pg8 {
#define PG8_LAS __attribute__((address_space(3)))
typedef unsigned short bf16_t;
typedef short bf16x8 __attribute__((ext_vector_type(8)));
typedef float f32x4 __attribute__((ext_vector_type(4)));
typedef unsigned u32x4 __attribute__((ext_vector_type(4)));
constexpr int BM = 256, BK = 64, HALF = 128, HTB = HALF * BK * 2  , STAGE_BYTES = 8 * HTB, NXCD = 8, WGM = 8;

__host__ __device__ __forceinline__ int lds_byte(int r, int c) { const int st = (r >> 4) * 2 + (c >> 5), rr = r & 15, cc = c & 31, ob = rr * 64 + cc * 2; return st * 1024 + (ob ^ (((ob >> 9) & 1) << 5)); }
__host__ __device__ __forceinline__ void stage_rc(int b, int& R, int& C) { const int st = b / 1024, sb = b % 1024, swz = sb ^ (((sb >> 9) & 1) << 5); R = (st >> 1) * 16 + swz / 64; C = (st & 1) * 32 + (swz % 64) / 2; }
__host__ __device__ __forceinline__ int perm32(int rho) { const int n = rho >> 4, i = rho & 15; return 8 * (i >> 2) + 4 * n + (i & 3); }

struct Unit { int pm, pn; };
struct Gemm { const bf16_t* A; const bf16_t* Bt; int M, N, K; };

struct StaticOrder {
    int nM, nN, nwg, G, c;
    __host__ __device__ void init(int M, int N, int G_, int c_) { nM = M / BM; nN = N / BM; nwg = nM * nN; G = G_; c = c_; }
    __host__ __device__ bool next(int i, Unit& u) const {
        const long L = (long)i * G + c; if (L >= nwg) return false;
        int wgid = (int)L; { const int q = nwg / NXCD, r = nwg % NXCD, xcd = wgid % NXCD, off = wgid / NXCD; wgid = (xcd < r ? xcd * (q + 1) : r * (q + 1) + (xcd - r) * q) + off; }
        const int nig = WGM * nN, gid = wgid / nig, fm = gid * WGM, gsz = (nM - fm) < WGM ? (nM - fm) : WGM;
        u.pm = fm + ((wgid % nig) % gsz); u.pn = (wgid % nig) / gsz; return true;
    }
    __device__ __forceinline__ void a_ready(const Unit&) const {}
    __device__ __forceinline__ void done(const Unit&) const {}
};
__device__ __forceinline__ unsigned cvt_pk_bf16(float lo, float hi) { unsigned r; asm volatile("v_cvt_pk_bf16_f32 %0, %1, %2" : "=v"(r) : "v"(lo), "v"(hi)); return r; }
typedef float f32x2 __attribute__((ext_vector_type(2)));
template <class Epi, class Sched, bool STAMP = false>
__device__ __forceinline__ void gemm_phase(PG8_LAS unsigned char* lds, const Gemm g, const Sched& S, const Epi& E, unsigned long long* stamps) {
    int tid_o = threadIdx.x; asm volatile("" : "+v"(tid_o));
    const int tid = tid_o, wid = __builtin_amdgcn_readfirstlane(tid >> 6), lane = tid & 63, wr = wid >> 2, wc = wid & 3, fr = lane & 15, fq = lane >> 4;
    const int K = g.K, nt = K / BK;
    int ts_lo = 0, ts_hi = 0, nts = 0; const unsigned long long rt_entry = STAMP ? (unsigned long long)wall_clock64() : 0ull;
#define PG8_STAMP() do { if (STAMP && wid == 0 && nts < 64) { const unsigned long long _c = (unsigned long long)clock64(); \
        ts_lo = (lane == nts) ? (int)(unsigned)_c : ts_lo; ts_hi = (lane == nts) ? (int)(unsigned)(_c >> 32) : ts_hi; ++nts; } } while (0)
    PG8_STAMP();
    unsigned voffA[2], voffB[2];
#pragma unroll
    for (int i = 0; i < 2; ++i) { int R, C; stage_rc(tid * 16 + i * 8192, R, C); const int Rb = Epi::PERM ? ((R & ~31) + perm32(R & 31)) : R;
        voffA[i] = (unsigned)(R * K + C) * 2u; voffB[i] = (unsigned)(Rb * K + C) * 2u; }
    const size_t kstep = (size_t)(BK * 2);
    const size_t hstep = (size_t)HALF * K * 2;
    const size_t tstep = 2 * hstep;
    const unsigned ldsw = (unsigned)wid * 1024u;
    const int aoff = lds_byte(wr * 64 + fr, fq * 8), boff = lds_byte(wc * 32 + fr, fq * 8);
#define PG8_SA(b, h) (((b) * 2 + (h)) * HTB)
#define PG8_SB(b, h) ((4 + (b) * 2 + (h)) * HTB)
#define PG8_STAGE(bufoff, gbase, voff) do { _Pragma("unroll") for (int _i = 0; _i < 2; ++_i) \
        __builtin_amdgcn_global_load_lds((const unsigned*)((const char*)(gbase) + (voff)[_i]), (PG8_LAS unsigned*)(lds + (bufoff) + ldsw + _i * 8192), 16, 0, 0); } while (0)
#define PG8_LDA(dst, b, h) do { _Pragma("unroll") for (int m = 0; m < 4; ++m) _Pragma("unroll") for (int k = 0; k < 2; ++k) dst[m][k] = *(const PG8_LAS bf16x8*)(lds + PG8_SA(b, h) + aoff + m * 2048 + k * 1024); } while (0)
#define PG8_LDB(dst, b, h) do { _Pragma("unroll") for (int n = 0; n < 2; ++n) _Pragma("unroll") for (int k = 0; k < 2; ++k) dst[n][k] = *(const PG8_LAS bf16x8*)(lds + PG8_SB(b, h) + boff + n * 2048 + k * 1024); } while (0)
#define PG8_MMA(ai, bj, At, Bt) do { __builtin_amdgcn_s_setprio(1); _Pragma("unroll") for (int m = 0; m < 4; ++m) _Pragma("unroll") for (int n = 0; n < 2; ++n) _Pragma("unroll") for (int k = 0; k < 2; ++k) \
        acc[ai][bj][m][n] = __builtin_amdgcn_mfma_f32_16x16x32_bf16(Bt[n][k], At[m][k], acc[ai][bj][m][n], 0, 0, 0); __builtin_amdgcn_s_setprio(0); } while (0)
#define PG8_WAIT_V(n) asm volatile("s_waitcnt vmcnt(" #n ")" ::: "memory")
#define PG8_WAIT_L(n) asm volatile("s_waitcnt lgkmcnt(" #n ")" ::: "memory")
#define PG8_BAR __builtin_amdgcn_s_barrier()
#define PG8_SCHED __builtin_amdgcn_sched_barrier(0)
    Unit cur, nxt; int ui = 0;
    if (!S.next(0, cur)) return;
    f32x4 acc[2][2][4][2];
#pragma unroll
    for (int a = 0; a < 2; ++a)
#pragma unroll
        for (int b = 0; b < 2; ++b)
#pragma unroll
            for (int m = 0; m < 4; ++m)
#pragma unroll
                for (int n = 0; n < 2; ++n) acc[a][b][m][n] = (f32x4){0.f, 0.f, 0.f, 0.f};
    bf16x8 At[4][2], B0[2][2], B1[2][2];
    const char* cA = (const char*)g.A + (size_t)cur.pm * tstep; const char* cB = (const char*)g.Bt + (size_t)cur.pn * tstep;
    S.a_ready(cur);
    PG8_STAGE(PG8_SB(0, 0), cB, voffB); PG8_STAGE(PG8_SA(0, 0), cA, voffA); PG8_STAGE(PG8_SB(0, 1), cB + hstep, voffB); PG8_STAGE(PG8_SA(0, 1), cA + hstep, voffA);
    if (wr == 1) PG8_BAR;
    PG8_WAIT_V(4); PG8_BAR;
    PG8_STAGE(PG8_SB(1, 0), cB + kstep, voffB); PG8_STAGE(PG8_SA(1, 0), cA + kstep, voffA); PG8_STAGE(PG8_SB(1, 1), cB + hstep + kstep, voffB);
    PG8_WAIT_V(6); PG8_BAR;
    PG8_STAMP();
    for (;;) {
        const bool has_next = S.next(ui + 1, nxt);
        const char* nA = has_next ? (const char*)g.A + (size_t)nxt.pm * tstep : cA; const char* nB = has_next ? (const char*)g.Bt + (size_t)nxt.pn * tstep : cB;
        for (int t = 0; t < nt; t += 2) {
            const bool last = (t == nt - 2);
            const char* a1 = cA + (size_t)(t + 1) * kstep;
            const char* a2 = last ? nA : cA + (size_t)(t + 2) * kstep; const char* b2 = last ? nB : cB + (size_t)(t + 2) * kstep;
            const char* a3 = a2 + kstep; const char* b3 = b2 + kstep;
            if (last && has_next) S.a_ready(nxt);
            PG8_LDB(B0, 0, 0); PG8_SCHED; PG8_LDA(At, 0, 0); PG8_STAGE(PG8_SA(1, 1), a1 + hstep, voffA);
            PG8_WAIT_L(8); PG8_BAR; PG8_WAIT_L(0); PG8_MMA(0, 0, At, B0); PG8_BAR; PG8_SCHED;
            PG8_LDB(B1, 0, 1); PG8_STAGE(PG8_SB(0, 0), b2, voffB);
            PG8_BAR; PG8_WAIT_L(0); PG8_MMA(0, 1, At, B1); PG8_BAR;
            PG8_LDA(At, 0, 1); PG8_STAGE(PG8_SA(0, 0), a2, voffA);
            PG8_BAR; PG8_WAIT_L(0); PG8_MMA(1, 0, At, B0); PG8_BAR; PG8_SCHED;
            PG8_STAGE(PG8_SB(0, 1), b2 + hstep, voffB);
            PG8_WAIT_V(6); PG8_BAR; PG8_MMA(1, 1, At, B1); PG8_BAR;
            PG8_LDB(B0, 1, 0); PG8_SCHED; PG8_LDA(At, 1, 0); PG8_STAGE(PG8_SA(0, 1), a2 + hstep, voffA);
            PG8_WAIT_L(8); PG8_BAR; PG8_WAIT_L(0); PG8_MMA(0, 0, At, B0); PG8_BAR; PG8_SCHED;
            PG8_LDB(B1, 1, 1); PG8_STAGE(PG8_SB(1, 0), b3, voffB);
            PG8_BAR; PG8_WAIT_L(0); PG8_MMA(0, 1, At, B1); PG8_BAR;
            PG8_LDA(At, 1, 1); PG8_STAGE(PG8_SA(1, 0), a3, voffA);
            PG8_BAR; PG8_WAIT_L(0); PG8_MMA(1, 0, At, B0); PG8_BAR; PG8_SCHED;
            PG8_STAGE(PG8_SB(1, 1), b3 + hstep, voffB);
            PG8_WAIT_V(6); PG8_BAR; PG8_MMA(1, 1, At, B1); PG8_BAR;
        }
        PG8_STAMP();
        if constexpr (!Epi::AFTER_DRAIN) { E(acc, cur, wr, wc, fr, fq); S.done(cur); }
        PG8_STAMP();
        if (!has_next) break;
#pragma unroll
        for (int a = 0; a < 2; ++a)
#pragma unroll
            for (int b = 0; b < 2; ++b)
#pragma unroll
                for (int m = 0; m < 4; ++m)
#pragma unroll
                    for (int n = 0; n < 2; ++n) acc[a][b][m][n] = (f32x4){0.f, 0.f, 0.f, 0.f};
        cur = nxt; cA = nA; cB = nB; ++ui;
    }
    PG8_WAIT_V(0);
    if (wr == 0) PG8_BAR;
    PG8_BAR;
    if constexpr (Epi::AFTER_DRAIN) { E.fused(acc, cur, wr, wc, fr, fq, lds, wid, lane); S.done(cur); }
    PG8_STAMP();
    if (STAMP && wid == 0) { stamps[lane] = lane < nts ? (((unsigned long long)(unsigned)ts_hi << 32) | (unsigned)ts_lo) : 0ull;
        if (lane == 62) stamps[62] = rt_entry; if (lane == 63) stamps[63] = (unsigned long long)wall_clock64(); }
#undef PG8_STAMP
#undef PG8_SA
#undef PG8_SB
#undef PG8_STAGE
#undef PG8_LDA
#undef PG8_LDB
#undef PG8_MMA
#undef PG8_WAIT_V
#undef PG8_WAIT_L
#undef PG8_BAR
#undef PG8_SCHED
}
}

using pg8::bf16_t; using pg8::bf16x8; using pg8::f32x4; using pg8::u32x4; using pg8::Unit; using pg8::cvt_pk_bf16;
typedef float f32x16 __attribute__((ext_vector_type(16)));
typedef float f32x2v __attribute__((ext_vector_type(2)));
typedef unsigned u32x2 __attribute__((ext_vector_type(2)));
typedef _Float16 half_t;
typedef _Float16 h4 __attribute__((ext_vector_type(4)));
typedef _Float16 h8 __attribute__((ext_vector_type(8)));
#define LAS PG8_LAS

#define XB_TMO      128
#define XB_XCNT(j)  (256  + 64 * (j))
#define XB_XSUB(j)  (1280 + 64 * (j))
#define XB_XGEN(j)  (2304 + 64 * (j))
#define XB_TOP      3328
#define XB_TOPGEN   3392
#define XCD_BAR_WORDS 3456
#define XB_SPIN_CAP (1u << 18)

__device__ __forceinline__ unsigned xb_ld(unsigned* p)              { return __hip_atomic_load(p, __ATOMIC_RELAXED, __HIP_MEMORY_SCOPE_AGENT); }
__device__ __forceinline__ unsigned xb_add(unsigned* p, unsigned v) { return __hip_atomic_fetch_add(p, v, __ATOMIC_RELAXED, __HIP_MEMORY_SCOPE_AGENT); }
__device__ __forceinline__ unsigned xb_xcc_id() { return (unsigned)__builtin_amdgcn_s_getreg((3 << 11) | 20) & 0xFu; }
#define XB_SPIN(cond, bar) do { unsigned _sp = 0; while (cond) { __builtin_amdgcn_s_sleep(1); \
    if ((++_sp & 255u) == 0u) { if (xb_ld(&(bar)[XB_TMO])) break; if (_sp > XB_SPIN_CAP) { atomicAdd(&(bar)[XB_TMO], 1u); break; } } } } while (0)

struct XcdBarrier {
    unsigned* bar; unsigned x;
    volatile LAS unsigned* st;
};

__device__ __forceinline__ XcdBarrier xcd_barrier_post(unsigned* bar, volatile LAS unsigned* st) {
    XcdBarrier b; b.bar = bar; b.x = xb_xcc_id(); b.st = st;
    if (threadIdx.x == 0) (void)xb_add(&bar[XB_XCNT(b.x)], 1u);
    return b;
}
__device__ __forceinline__ void xcd_barrier_complete(unsigned* bar, unsigned x, unsigned& nloc, unsigned& nx) {
    const unsigned G = gridDim.x * gridDim.y * gridDim.z;
    unsigned sum, cnt, mine, sp = 0u;
    for (;;) {
        sum = 0u; cnt = 0u; mine = 0u;
#pragma unroll
        for (unsigned j = 0; j < 16; ++j) { const unsigned c = xb_ld(&bar[XB_XCNT(j)]); sum += c; cnt += (c > 0u) ? 1u : 0u; mine = (j == x) ? c : mine; }
        if (sum == G) break;
        __builtin_amdgcn_s_sleep(1);
        if ((++sp & 255u) == 0u) { if (xb_ld(&bar[XB_TMO])) break; if (sp > XB_SPIN_CAP) { atomicAdd(&bar[XB_TMO], 1u); break; } }
    }
    nloc = mine > 0u ? mine : 1u; nx = cnt > 0u ? cnt : 1u;
}

__device__ __forceinline__ void xcd_barrier(const XcdBarrier& b) {
    asm volatile("s_waitcnt vmcnt(0)" ::: "memory");
    __syncthreads();
    if (threadIdx.x == 0) {
        unsigned* bar = b.bar;
        __builtin_amdgcn_s_waitcnt(0);
        unsigned nloc = b.st[0], nx = b.st[1];
        if (nloc == 0u) { xcd_barrier_complete(bar, b.x, nloc, nx); b.st[0] = nloc; b.st[1] = nx; }
        const unsigned old = xb_add(&bar[XB_XSUB(b.x)], 1u);
        const unsigned gen = old / nloc;
        if (old + 1u == (gen + 1u) * nloc) {
            __builtin_amdgcn_fence(__ATOMIC_RELEASE, "agent");
            asm volatile("s_waitcnt vmcnt(0)" ::: "memory");
            const unsigned og = xb_add(&bar[XB_TOP], 1u);
            const unsigned tg = og / nx;
            if (og + 1u == (tg + 1u) * nx) xb_add(&bar[XB_TOPGEN], 1u);
            else XB_SPIN(xb_ld(&bar[XB_TOPGEN]) == tg, bar);
            __builtin_amdgcn_fence(__ATOMIC_ACQUIRE, "agent");
            xb_add(&bar[XB_XGEN(b.x)], 1u);
            asm volatile("s_waitcnt vmcnt(0)" ::: "memory");
        } else {
            XB_SPIN(xb_ld(&bar[XB_XGEN(b.x)]) == gen, bar);
            __builtin_amdgcn_fence(__ATOMIC_ACQUIRE, "agent");
            asm volatile("s_waitcnt vmcnt(0)" ::: "memory");
        }
    }
    __syncthreads();
}


constexpr int D = 1024, MCTX = 4096, MTOT = 36864, DFF = 2816, NFI = 5632, NMI = 1536;
constexpr float ALPHA = 1.6817928305074290f;
constexpr float LN_EPS = 1e-5f;
constexpr int LDS_BYTES = 131072 + 16;
constexpr int OUT_RE = MTOT * D, OUT_IM = OUT_RE + 16 * 4 * 2 * 16 * 64, OUT_TOTAL = OUT_IM + 16 * 4 * 2 * 16 * 64;

constexpr size_t al256(size_t x) { return (x + 255) & ~(size_t)255; }
constexpr size_t WS_WFI = 0;
constexpr size_t WS_WFO = WS_WFI + (size_t)8 * NFI * D * 2;
constexpr size_t WS_WMI = WS_WFO + (size_t)8 * D * DFF * 2;
constexpr size_t WS_WMO = WS_WMI + (size_t)4 * NMI * D * 2;
constexpr size_t WS_WGLU = WS_WMO + (size_t)4 * D * D * 2;
constexpr size_t WS_WSGU = WS_WGLU + (size_t)4 * 256 * 256 * 2;
constexpr size_t WS_MOD = WS_WSGU + (size_t)4 * 4 * 128 * 128 * 2;
constexpr size_t WS_DL = al256(WS_MOD + (size_t)4 * 9 * 9216 * 4);
constexpr size_t WS_DC = WS_DL + (size_t)4096 * 8192 * 2;
constexpr size_t WS_S5A = WS_DC + (size_t)256 * 512 * 2;
constexpr size_t WS_S5B = WS_S5A + (size_t)128 * 64 * 8;
constexpr size_t WS_S5C = WS_S5B + (size_t)128 * 128 * 16 * 2;
constexpr size_t WS_PE = WS_S5C + (size_t)128 * 16 * 128 * 2;
constexpr size_t WS_STATS = WS_PE + (size_t)64 * 512 * 4;
constexpr size_t WS_H = WS_STATS + (size_t)MTOT * 2 * 4;
constexpr size_t WS_BIG = WS_H + (size_t)MTOT * D * 2;
constexpr size_t WS_ACT = WS_BIG;
constexpr size_t WS_Z = WS_BIG;
constexpr size_t WS_PTL = WS_Z + (size_t)MTOT * D * 2;
constexpr size_t WS_PTC = WS_PTL + (size_t)2048 * 8192 * 2;
constexpr size_t WS_YF = WS_PTC + (size_t)4096 * 512 * 2;
constexpr size_t WS_YB = WS_YF + (size_t)MTOT * 256 * 2;
constexpr size_t WS_YF1 = WS_YB + (size_t)MTOT * 256 * 2;
constexpr size_t WS_YB1 = WS_YF1 + (size_t)MTOT * 256 * 2;
constexpr size_t WS_YA = WS_YB1 + (size_t)MTOT * 256 * 2;
constexpr size_t WS_VNT = WS_YA + (size_t)MTOT * 256 * 2;
constexpr size_t WS_YCAT = WS_VNT + (size_t)1152 * 64 * 128 * 2;
constexpr size_t WS_END_MIX = WS_YCAT + (size_t)MTOT * D * 2;
constexpr size_t WS_END_ACT = WS_ACT + (size_t)MTOT * DFF * 2;
constexpr size_t WS_V = WS_END_MIX > WS_END_ACT ? WS_END_MIX : WS_END_ACT;
constexpr size_t WS_BAR = WS_V + (size_t)MTOT * D * 2;
constexpr size_t WS_END = WS_BAR + (size_t)XCD_BAR_WORDS * 4;

struct Args { const float* in[30]; float* out; unsigned char* ws; };

typedef const float* cfp_t;
typedef const __attribute__((address_space(4))) unsigned char* kaptr_t;
__device__ __forceinline__ const unsigned char* ka_load(int byte_off) {
    kaptr_t ka = (kaptr_t)__builtin_amdgcn_kernarg_segment_ptr(); asm volatile("" : "+s"(ka));
    typedef __attribute__((address_space(1))) unsigned char* gptr_t;
    const gptr_t g = *(const gptr_t __attribute__((address_space(4)))*)(ka + byte_off);
    return (const unsigned char*)g;
}
struct InProxy { __device__ __forceinline__ const float* operator[](int i) const { return (const float*)ka_load(8 * i); } };
struct Ctx {
    InProxy in;
    float* out;
    unsigned char* ws;
    __device__ __forceinline__ half_t* v() const { return (half_t*)(ws + WS_V); }
    __device__ __forceinline__ bf16_t* wfi() const { return (bf16_t*)(ws + WS_WFI); }
    __device__ __forceinline__ bf16_t* wfo() const { return (bf16_t*)(ws + WS_WFO); }
    __device__ __forceinline__ bf16_t* wmi() const { return (bf16_t*)(ws + WS_WMI); }
    __device__ __forceinline__ bf16_t* wmo() const { return (bf16_t*)(ws + WS_WMO); }
    __device__ __forceinline__ bf16_t* wglu() const { return (bf16_t*)(ws + WS_WGLU); }
    __device__ __forceinline__ bf16_t* wsgu() const { return (bf16_t*)(ws + WS_WSGU); }
    __device__ __forceinline__ float* mod() const { return (float*)(ws + WS_MOD); }
    __device__ __forceinline__ bf16_t* dl() const { return (bf16_t*)(ws + WS_DL); }
    __device__ __forceinline__ bf16_t* dc() const { return (bf16_t*)(ws + WS_DC); }
    __device__ __forceinline__ f32x2v* s5a() const { return (f32x2v*)(ws + WS_S5A); }
    __device__ __forceinline__ bf16_t* s5b() const { return (bf16_t*)(ws + WS_S5B); }
    __device__ __forceinline__ bf16_t* s5c() const { return (bf16_t*)(ws + WS_S5C); }
    __device__ __forceinline__ float* pe() const { return (float*)(ws + WS_PE); }
    __device__ __forceinline__ f32x2v* stats() const { return (f32x2v*)(ws + WS_STATS); }
    __device__ __forceinline__ bf16_t* h() const { return (bf16_t*)(ws + WS_H); }
    __device__ __forceinline__ bf16_t* act() const { return (bf16_t*)(ws + WS_ACT); }
    __device__ __forceinline__ bf16_t* z() const { return (bf16_t*)(ws + WS_Z); }
    __device__ __forceinline__ bf16_t* ptl() const { return (bf16_t*)(ws + WS_PTL); }
    __device__ __forceinline__ bf16_t* ptc() const { return (bf16_t*)(ws + WS_PTC); }
    __device__ __forceinline__ bf16_t* ypart(int i) const { return (bf16_t*)(ws + WS_YF) + (size_t)i * MTOT * 256; }
    __device__ __forceinline__ bf16_t* yf() const { return (bf16_t*)(ws + WS_YF); }
    __device__ __forceinline__ bf16_t* yb() const { return (bf16_t*)(ws + WS_YB); }
    __device__ __forceinline__ bf16_t* ya() const { return (bf16_t*)(ws + WS_YA); }
    __device__ __forceinline__ bf16_t* vnt() const { return (bf16_t*)(ws + WS_VNT); }
    __device__ __forceinline__ bf16_t* ycat() const { return (bf16_t*)(ws + WS_YCAT); }
};
#define OPAQUE_CTX(X, Xin) Ctx X; X.out = (float*)ka_load(240); X.ws = (unsigned char*)ka_load(248); (void)Xin


__device__ __forceinline__ float bf2f(bf16_t x) { return __uint_as_float(((unsigned)x) << 16); }
__device__ __forceinline__ float bflo(unsigned w) { return __uint_as_float(w << 16); }
__device__ __forceinline__ float bfhi(unsigned w) { return __uint_as_float(w & 0xffff0000u); }
__device__ __forceinline__ bf16_t f2bf(float x) { return (bf16_t)(cvt_pk_bf16(x, 0.f) & 0xffffu); }
__device__ __forceinline__ float sigmoidf_(float x) { return __builtin_amdgcn_rcpf(1.0f + __builtin_amdgcn_exp2f(-1.4426950408889634f * x)); }
__device__ __forceinline__ float siluf_(float x) { return x * __builtin_amdgcn_rcpf(1.0f + __builtin_amdgcn_exp2f(-1.4426950408889634f * x)); }
__device__ __forceinline__ float geluf_(float x) { const float t = -2.3022081986f * (x + 0.044715f * x * x * x); return x * __builtin_amdgcn_rcpf(1.0f + __builtin_amdgcn_exp2f(t)); }
__device__ __forceinline__ int otid() { int t = threadIdx.x; asm volatile("" : "+v"(t)); return t; }
__device__ __forceinline__ float wave_sum(float x) {
#pragma unroll
    for (int o = 32; o > 0; o >>= 1) x += __shfl_xor(x, o);
    return x;
}

struct TcItem { const float* src; bf16_t* dst; int ldsrc, lddst, k0, n0s, n0d; };
__device__ __forceinline__ TcItem tc_decode(const Ctx& X, int it) {
    TcItem p;
    if (it < 11264) { const int li = it / 1408, rem = it % 1408, kt = rem / 88, nt = rem % 88;
        p.src = X.in[8] + (size_t)li * D * NFI; p.ldsrc = NFI; p.dst = X.wfi() + (size_t)li * NFI * D; p.lddst = D; p.k0 = kt * 64; p.n0s = nt * 64;
        if (p.n0s < DFF) p.n0d = (p.n0s >> 7) * 256 + (p.n0s & 127); else { const int j = p.n0s - DFF; p.n0d = (j >> 7) * 256 + 128 + (j & 127); } }
    else if (it < 16896) { const int i2 = it - 11264, li = i2 / 704, rem = i2 % 704, kt = rem / 16, nt = rem % 16;
        p.src = X.in[9] + (size_t)li * DFF * D; p.ldsrc = D; p.dst = X.wfo() + (size_t)li * D * DFF; p.lddst = DFF; p.k0 = kt * 64; p.n0s = nt * 64; p.n0d = p.n0s; }
    else if (it < 17152) { const int i2 = it - 16896, l = i2 / 64, rem = i2 % 64, kt = rem / 4, nt = rem % 4;
        p.src = X.in[10] + (size_t)l * D * 1280; p.ldsrc = 1280; p.dst = X.wmi() + (size_t)l * NMI * D; p.lddst = D; p.k0 = kt * 64; p.n0s = nt * 64; p.n0d = p.n0s; }
    else if (it < 17664) { const int i2 = it - 17152, l = i2 / 128, rem = i2 % 128, kt = rem / 8, nt = rem % 8;
        p.src = X.in[10] + (size_t)l * D * 1280; p.ldsrc = 1280; p.dst = X.wmi() + (size_t)l * NMI * D; p.lddst = D; p.k0 = kt * 64; p.n0s = 768 + nt * 64; p.n0d = 1024 + nt * 64; }
    else if (it < 18688) { const int i2 = it - 17664, l = i2 / 256, rem = i2 % 256, kt = rem / 16, nt = rem % 16;
        p.src = X.in[11] + (size_t)l * D * D; p.ldsrc = D; p.dst = X.wmo() + (size_t)l * D * D; p.lddst = D; p.k0 = kt * 64; p.n0s = nt * 64; p.n0d = p.n0s; }
    else { const int i2 = it - 18688, l = i2 / 16, rem = i2 % 16, kt = rem / 4, nt = rem % 4;
        p.src = X.in[21] + (size_t)l * 65536; p.ldsrc = 256; p.dst = X.wglu() + (size_t)l * 65536; p.lddst = 256; p.k0 = kt * 64; p.n0s = nt * 64; p.n0d = p.n0s; }
    return p;
}

__device__ __forceinline__ int t1_map(int layer, int j) {
    if (j < 2816) return layer * 2816 + j;
    if (j < 4224) return 11264 + layer * 1408 + (j - 2816);
    if (j < 4288) return 16896 + layer * 64 + (j - 4224);
    if (j < 4416) return 17152 + layer * 128 + (j - 4288);
    if (j < 4672) return 17664 + layer * 256 + (j - 4416);
    return 18688 + layer * 16 + (j - 4672);
}
__device__ __forceinline__ void wave_tconv(const Ctx& Xin, LAS float* tile, int it) {
    OPAQUE_CTX(X, Xin);
    const int lane = otid() & 63;
    const TcItem p = tc_decode(X, it);
    const int rr = lane >> 4, cc = (lane & 15) * 4;
    f32x4 v[16];
#pragma unroll
    for (int i = 0; i < 16; ++i) v[i] = *(const f32x4*)(p.src + (size_t)(p.k0 + rr + 4 * i) * p.ldsrc + p.n0s + cc);
#pragma unroll
    for (int i = 0; i < 16; ++i) { const int r = rr + 4 * i; tile[r * 65 + cc + 0] = v[i][0]; tile[r * 65 + cc + 1] = v[i][1]; tile[r * 65 + cc + 2] = v[i][2]; tile[r * 65 + cc + 3] = v[i][3]; }
    asm volatile("s_waitcnt lgkmcnt(0)" ::: "memory");
    const int k8 = (lane & 7) * 8;
#pragma unroll
    for (int ps = 0; ps < 8; ++ps) {
        const int n = (lane >> 3) + 8 * ps;
        float x[8];
#pragma unroll
        for (int j = 0; j < 8; ++j) x[j] = tile[(k8 + j) * 65 + n];
        u32x4 w; w.x = cvt_pk_bf16(x[0], x[1]); w.y = cvt_pk_bf16(x[2], x[3]); w.z = cvt_pk_bf16(x[4], x[5]); w.w = cvt_pk_bf16(x[6], x[7]);
        *(u32x4*)(p.dst + (size_t)(p.n0d + n) * p.lddst + p.k0 + k8) = w;
    }
    asm volatile("s_waitcnt lgkmcnt(0)" ::: "memory");
}

__device__ __forceinline__ void phase0(const Ctx& Xin, LAS unsigned char* lds) {
    OPAQUE_CTX(X, Xin);
    const int tid = otid(), lane = tid & 63, wave = tid >> 6, G = gridDim.x, bid = blockIdx.x;
#ifndef P0MASK
#define P0MASK 0xFF
#endif
#define P0(k) if ((P0MASK >> (k)) & 1)
    P0(0) {
        LAS float* tile = (LAS float*)lds;
        const int r0 = tid >> 4, c0 = (tid & 15) * 4, nn = tid >> 3, k8 = (tid & 7) * 8;
        int jl = bid; int it = (jl < 4688) ? t1_map(0, jl) : 18752;
        f32x4 va = {0.f, 0.f, 0.f, 0.f}, vb = va;
        TcItem p;
        if (it < 18752) { p = tc_decode(X, it);
            va = *(const f32x4*)(p.src + (size_t)(p.k0 + r0) * p.ldsrc + p.n0s + c0); vb = *(const f32x4*)(p.src + (size_t)(p.k0 + r0 + 32) * p.ldsrc + p.n0s + c0); }
        while (it < 18752) {
            tile[r0 * 65 + c0 + 0] = va[0]; tile[r0 * 65 + c0 + 1] = va[1]; tile[r0 * 65 + c0 + 2] = va[2]; tile[r0 * 65 + c0 + 3] = va[3];
            tile[(r0 + 32) * 65 + c0 + 0] = vb[0]; tile[(r0 + 32) * 65 + c0 + 1] = vb[1]; tile[(r0 + 32) * 65 + c0 + 2] = vb[2]; tile[(r0 + 32) * 65 + c0 + 3] = vb[3];
            __syncthreads();
            bf16_t* dstp = p.dst + (size_t)(p.n0d + nn) * p.lddst + p.k0 + k8;
            jl += G; it = (jl < 4688) ? t1_map(0, jl) : 18752;
            if (it < 18752) { p = tc_decode(X, it);
                va = *(const f32x4*)(p.src + (size_t)(p.k0 + r0) * p.ldsrc + p.n0s + c0); vb = *(const f32x4*)(p.src + (size_t)(p.k0 + r0 + 32) * p.ldsrc + p.n0s + c0); }
            float x[8];
#pragma unroll
            for (int j = 0; j < 8; ++j) x[j] = tile[(k8 + j) * 65 + nn];
            u32x4 w; w.x = cvt_pk_bf16(x[0], x[1]); w.y = cvt_pk_bf16(x[2], x[3]); w.z = cvt_pk_bf16(x[4], x[5]); w.w = cvt_pk_bf16(x[6], x[7]);
            *(u32x4*)dstp = w;
            __syncthreads();
        }
    }
    __syncthreads();
    P0(1) {
        LAS float* T = (LAS float*)lds;
        LAS float* ctab = (LAS float*)(lds + 32768);
        for (int u = bid; u < 256; u += G) {
            const int layer = u >> 6, kind = (u >> 3) & 7, kb = u & 7;
            if (tid < 64) ctab[tid] = cospif((float)tid * (1.0f / 32.0f));
            __syncthreads();
            if (kind < 4) {
                const float* fw = X.in[23] + (size_t)(layer * 4 + kind) * 4096;
                for (int e = tid; e < 8192; e += 512) {
                    const int c = e >> 7, j = e & 127, d = j & 63, sn = j >> 6;
                    float acc = 0.f;
                    for (int cp = 0; cp < 64; ++cp) { const int m = (c * cp - 16 * sn) & 63; acc += ctab[m] * fw[cp * 64 + d]; }
                    T[e] = acc;
                }
            } else {
                const float* pw = X.in[24] + (size_t)(layer * 4 + (kind - 4)) * 4096;
                for (int e = tid; e < 8192; e += 512) { const int c = e >> 7, j = e & 127; T[e] = (j < 64) ? pw[c * 64 + j] : 0.f; }
            }
            __syncthreads();
            {
                const int k = kb * 128 + (tid & 127), js = tid >> 7;
                const int coff = (kind < 4) ? 256 + kind * 64 : 512 + (kind - 4) * 64;
                const float* wr = X.in[10] + ((size_t)(layer * D + k)) * 1280 + coff;
                bf16_t* dstl = X.wmi() + (size_t)layer * NMI * D;
                f32x4 acc[8];
#pragma unroll
                for (int q = 0; q < 8; ++q) acc[q] = (f32x4){0.f, 0.f, 0.f, 0.f};
#pragma unroll 2
                for (int c = 0; c < 64; ++c) {
                    const float w = wr[c];
#pragma unroll
                    for (int q = 0; q < 8; ++q) acc[q] += w * *(LAS f32x4*)(T + c * 128 + js * 32 + q * 4);
                }
#pragma unroll
                for (int q = 0; q < 8; ++q)
#pragma unroll
                    for (int e = 0; e < 4; ++e) {
                        const int jc = js * 32 + q * 4 + e;
                        int n;
                        if (kind < 4) n = (jc < 64) ? (256 + kind * 64 + jc) : (512 + kind * 64 + (jc - 64));
                        else n = 768 + (kind - 4) * 64 + jc;
                        if (kind < 4 || jc < 64) dstl[(size_t)n * D + k] = f2bf(acc[q][e]);
                    }
            }
            __syncthreads();
        }
    }
    __syncthreads();
    P0(2) {
        LAS float* sv = (LAS float*)lds;
        LAS float* part = (LAS float*)(lds + 36864);
        for (int e = tid; e < 9 * 1024; e += 512) { const int cnd = e >> 10, k = e & 1023; const float c = (cnd < 8) ? X.in[2][cnd * 1024 + k] : X.in[5][k]; sv[e] = siluf_(c); }
        __syncthreads();
        for (int u = bid; u < 288; u += G) {
            const int layer = u / 72, chunk = u % 72, col = chunk * 128 + 2 * lane;
            float ax[9], ay[9];
#pragma unroll
            for (int c = 0; c < 9; ++c) { ax[c] = 0.f; ay[c] = 0.f; }
            const float* wp = X.in[6] + ((size_t)(layer * D + wave * 128)) * 9216 + col;
            for (int k = 0; k < 128; ++k) {
                const f32x2v wv = *(const f32x2v*)(wp + (size_t)k * 9216);
#pragma unroll
                for (int c = 0; c < 9; ++c) { const float s = sv[c * 1024 + wave * 128 + k]; ax[c] += s * wv.x; ay[c] += s * wv.y; }
            }
#pragma unroll
            for (int c = 0; c < 9; ++c) { part[(wave * 9 + c) * 128 + 2 * lane] = ax[c]; part[(wave * 9 + c) * 128 + 2 * lane + 1] = ay[c]; }
            __syncthreads();
            for (int e = tid; e < 1152; e += 512) {
                const int c = e >> 7, cc = e & 127; float s = 0.f;
#pragma unroll
                for (int w = 0; w < 8; ++w) s += part[(w * 9 + c) * 128 + cc];
                X.mod()[((size_t)(layer * 9 + c)) * 9216 + chunk * 128 + cc] = s + X.in[7][layer * 9216 + chunk * 128 + cc];
            }
            __syncthreads();
        }
    }
    __syncthreads();
    P0(3) {
        LAS float* tab = (LAS float*)lds;
        for (int m = tid; m < 4096; m += 512) tab[m] = cospif((float)m * (1.0f / 2048.0f));
        __syncthreads();
        for (int k = bid; k < 4096; k += G) {
#pragma unroll
            for (int i = 0; i < 2; ++i) {
                const int c8 = (tid + 512 * i) * 8;
                float x[8];
#pragma unroll
                for (int j = 0; j < 8; ++j) { const int col = c8 + j;
                    if (col < 4096) x[j] = tab[(k * col) & 4095] * (1.0f / 512.0f);
                    else x[j] = -tab[(k * (col - 4096) - 1024) & 4095] * (1.0f / 512.0f); }
                u32x4 w; w.x = cvt_pk_bf16(x[0], x[1]); w.y = cvt_pk_bf16(x[2], x[3]); w.z = cvt_pk_bf16(x[4], x[5]); w.w = cvt_pk_bf16(x[6], x[7]);
                *(u32x4*)(X.dl() + (size_t)k * 8192 + c8) = w;
            }
        }
        for (int k = bid; k < 256; k += G) {
            if (tid < 64) {
                const int c8 = tid * 8; float x[8];
#pragma unroll
                for (int j = 0; j < 8; ++j) { const int col = c8 + j;
                    if (col < 256) x[j] = tab[((k * col) & 255) * 16] * (1.0f / 128.0f);
                    else x[j] = -tab[((((k * (col - 256)) & 255) * 16) - 1024) & 4095] * (1.0f / 128.0f); }
                u32x4 w; w.x = cvt_pk_bf16(x[0], x[1]); w.y = cvt_pk_bf16(x[2], x[3]); w.z = cvt_pk_bf16(x[4], x[5]); w.w = cvt_pk_bf16(x[6], x[7]);
                *(u32x4*)(X.dc() + (size_t)k * 512 + c8) = w;
            }
        }
    }
    __syncthreads();
    P0(4) for (int u = bid; u < 128; u += G) {
        const float dt = expf(X.in[15][u]);
        for (int e = tid; e < 2048; e += 512) {
            const int col = e >> 4, ch = e & 15, blk = col >> 5, r = col & 31, p = r + 32 * (blk >> 1), ri = blk & 1;
            const float lr = X.in[13][u * 64 + p], li = X.in[14][u * 64 + p];
            const float ea = expf(lr * dt), ar = ea * cosf(li * dt), ai = ea * sinf(li * dt);
            const float den = lr * lr + li * li, nr = ar - 1.0f;
            const float cr = (nr * lr + ai * li) / den, ci = (ai * lr - nr * li) / den;
            const float br = X.in[16][((size_t)u * 64 + p) * 16 + ch], bi = X.in[17][((size_t)u * 64 + p) * 16 + ch];
            const float val = ri ? (cr * bi + ci * br) : (cr * br - ci * bi);
            X.s5b()[((size_t)u * 128 + col) * 16 + ch] = f2bf(val);
        }
        for (int e = tid; e < 2048; e += 512) {
            const int hp = e >> 7, kk = e & 127, r = kk >> 2, blk = kk & 3, p = r + 32 * (blk >> 1), ri = blk & 1;
            const float val = ri ? -X.in[19][((size_t)u * 16 + hp) * 64 + p] : X.in[18][((size_t)u * 16 + hp) * 64 + p];
            X.s5c()[((size_t)u * 16 + hp) * 128 + kk] = f2bf(val);
        }
        if (tid < 64) {
            const float lr = X.in[13][u * 64 + tid], li = X.in[14][u * 64 + tid];
            const float ea = expf(lr * dt);
            f32x2v a; a.x = ea * cosf(li * dt); a.y = ea * sinf(li * dt);
            X.s5a()[u * 64 + tid] = a;
        }
    }
    P0(5) {
        const size_t gt = (size_t)bid * 512 + tid, gs = (size_t)G * 512;
        for (size_t i = gt; i < (size_t)64 * 512; i += gs) {
            const int pos = (int)(i >> 9), cc = (int)(i & 511), ii = cc & 255;
            const float omega = 1.0f / powf(10000.0f, (float)ii * (1.0f / 256.0f));
            const float ang = (float)pos * omega;
            X.pe()[i] = (cc < 256) ? sinf(ang) : cosf(ang);
        }
        for (size_t i = gt; i < (size_t)4 * 4 * 128 * 128; i += gs) X.wsgu()[i] = f2bf(X.in[26][i]);
    }
}

__device__ __forceinline__ void lnmod_load(const Ctx& X, int row, int lane, bool first, f32x4 (&x)[4]) {
    if (!first) {
        const half_t* vr = X.v() + (size_t)row * D;
#pragma unroll
        for (int i = 0; i < 4; ++i) x[i] = __builtin_convertvector(*(const h4*)(vr + i * 256 + lane * 4), f32x4);
    } else if (row < MCTX) {
        const float* vr = X.in[0] + (size_t)row * D;
#pragma unroll
        for (int i = 0; i < 4; ++i) x[i] = *(const f32x4*)(vr + i * 256 + lane * 4);
    } else {
        const float* vr = X.in[1] + (size_t)(row - MCTX) * D;
        const int t = (row - MCTX) & 4095;
        const float* per = X.pe() + (size_t)(t >> 6) * 512, * pec = X.pe() + (size_t)(t & 63) * 512;
#pragma unroll
        for (int i = 0; i < 4; ++i) {
            const int col = i * 256 + lane * 4;
            x[i] = *(const f32x4*)(vr + col) + ((i < 2) ? *(const f32x4*)(per + col) : *(const f32x4*)(pec + col - 512));
        }
    }
}
__device__ __forceinline__ void lnmod_row(const Ctx& X, int row, int lane, bool first, bool do_ln, const f32x4 (&Gc)[4], const f32x4 (&Bc)[4], const float* modL, int sub, f32x4 (&x)[4], int& ccur, f32x4 (&SH)[4], f32x4 (&SC1)[4]) {
    float mean = 0.f, rstd = 1.f;
    if (do_ln) {
        float s = 0.f;
#pragma unroll
        for (int i = 0; i < 4; ++i) s += (x[i][0] + x[i][1]) + (x[i][2] + x[i][3]);
        mean = wave_sum(s) * (1.0f / 1024.0f);
        float q = 0.f;
#pragma unroll
        for (int i = 0; i < 4; ++i) { const f32x4 d = x[i] - mean; q += (d[0] * d[0] + d[1] * d[1]) + (d[2] * d[2] + d[3] * d[3]); }
        rstd = rsqrtf(wave_sum(q) * (1.0f / 1024.0f) + LN_EPS);
    }
    if (lane == 0) { f32x2v st; st.x = mean; st.y = rstd; X.stats()[row] = st; }
    const int cond = (row < MCTX) ? 8 : ((row - MCTX) >> 12);
    if (cond != ccur) {
        const float* sh = modL + (size_t)cond * 9216 + (sub * 3 + 0) * 1024;
        const float* sc = modL + (size_t)cond * 9216 + (sub * 3 + 1) * 1024;
#pragma unroll
        for (int i = 0; i < 4; ++i) { SH[i] = *(const f32x4*)(sh + i * 256 + lane * 4); SC1[i] = 1.0f + *(const f32x4*)(sc + i * 256 + lane * 4); }
        ccur = cond;
    }
#pragma unroll
    for (int i = 0; i < 4; ++i) {
        const int col = i * 256 + lane * 4;
        f32x4 xv = x[i];
        if (first) *(h4*)(X.v() + (size_t)row * D + col) = __builtin_convertvector(xv, h4);
        if (do_ln) xv = (xv - mean) * rstd * Gc[i] + Bc[i];
        const f32x4 hv = xv * SC1[i] + SH[i];
        u32x2 w; w.x = cvt_pk_bf16(hv[0], hv[1]); w.y = cvt_pk_bf16(hv[2], hv[3]);
        *(u32x2*)(X.h() + (size_t)row * D + col) = w;
    }
}
__device__ __forceinline__ void phase_lnmod(const Ctx& Xin, int layer, int sub, bool do_ln, const float* lnG, const float* lnB) {
    OPAQUE_CTX(X, Xin);
    const int tid_ = otid(), lane = tid_ & 63, gw = blockIdx.x * 8 + (tid_ >> 6), nw = gridDim.x * 8;
    const float* modL = X.mod() + (size_t)layer * 9 * 9216;
    const bool first = !do_ln;
    f32x4 Gc[4], Bc[4];
#pragma unroll
    for (int i = 0; i < 4; ++i) { Gc[i] = *(const f32x4*)(lnG + i * 256 + lane * 4); Bc[i] = *(const f32x4*)(lnB + i * 256 + lane * 4); }
    const int rpw = (MTOT + nw - 1) / nw, rbeg = gw * rpw, rend = (rbeg + rpw) < MTOT ? (rbeg + rpw) : MTOT;
    int ccur = -1; f32x4 SH[4], SC1[4];
    for (int row = rbeg; row < rend; row += 3) {
        const int rowb = row + 1, rowc = row + 2;
        f32x4 xa[4], xb[4], xc[4];
        lnmod_load(X, row, lane, first, xa);
        if (rowb < rend) lnmod_load(X, rowb, lane, first, xb);
        if (rowc < rend) lnmod_load(X, rowc, lane, first, xc);
        lnmod_row(X, row, lane, first, do_ln, Gc, Bc, modL, sub, xa, ccur, SH, SC1);
        if (rowb < rend) lnmod_row(X, rowb, lane, first, do_ln, Gc, Bc, modL, sub, xb, ccur, SH, SC1);
        if (rowc < rend) lnmod_row(X, rowc, lane, first, do_ln, Gc, Bc, modL, sub, xc, ccur, SH, SC1);
    }
}

__device__ __forceinline__ void phase_final_ln(const Ctx& Xin, const float* lnG, const float* lnB) {
    OPAQUE_CTX(X, Xin);
    const int tid_ = otid(), lane = tid_ & 63, gw = blockIdx.x * 8 + (tid_ >> 6), nw = gridDim.x * 8;
    for (int row = gw; row < MTOT; row += nw) {
        const half_t* vr = X.v() + (size_t)row * D;
        float* orow = X.out + (size_t)row * D;
        f32x4 x[4];
#pragma unroll
        for (int i = 0; i < 4; ++i) x[i] = __builtin_convertvector(*(const h4*)(vr + i * 256 + lane * 4), f32x4);
        float s = 0.f;
#pragma unroll
        for (int i = 0; i < 4; ++i) s += (x[i][0] + x[i][1]) + (x[i][2] + x[i][3]);
        const float mean = wave_sum(s) * (1.0f / 1024.0f);
        float q = 0.f;
#pragma unroll
        for (int i = 0; i < 4; ++i) { const f32x4 d = x[i] - mean; q += (d[0] * d[0] + d[1] * d[1]) + (d[2] * d[2] + d[3] * d[3]); }
        const float rstd = rsqrtf(wave_sum(q) * (1.0f / 1024.0f) + LN_EPS);
#pragma unroll
        for (int i = 0; i < 4; ++i) {
            const int col = i * 256 + lane * 4;
            *(f32x4*)(orow + col) = (x[i] - mean) * rstd * *(const f32x4*)(lnG + col) + *(const f32x4*)(lnB + col);
        }
    }
}

struct EpiSwiGLU {
    static constexpr bool PERM = true, AFTER_DRAIN = false;
    bf16_t* act;
    __device__ __forceinline__ void operator()(const f32x4 (&acc)[2][2][4][2], const Unit& u, int wr, int wc, int fr, int fq) const {
        const int row0 = u.pm * 256 + wr * 64 + fr, colo = u.pn * 128 + wc * 32 + 8 * fq;
#pragma unroll
        for (int ai = 0; ai < 2; ++ai)
#pragma unroll
            for (int m = 0; m < 4; ++m) {
                const int row = row0 + ai * 128 + m * 16;
                float o[8];
#pragma unroll
                for (int n = 0; n < 2; ++n)
#pragma unroll
                    for (int j = 0; j < 4; ++j) o[n * 4 + j] = siluf_(acc[ai][1][m][n][j]) * acc[ai][0][m][n][j];
                u32x4 w; w.x = cvt_pk_bf16(o[0], o[1]); w.y = cvt_pk_bf16(o[2], o[3]); w.z = cvt_pk_bf16(o[4], o[5]); w.w = cvt_pk_bf16(o[6], o[7]);
                *(u32x4*)(act + (size_t)row * DFF + colo) = w;
            }
    }
};

#ifdef PROBE_FFNOUT
constexpr long VOUT_DELTA_PROBE = ((long)(WS_ACT + (size_t)MTOT * DFF * 2) - (long)WS_V) / 2;
#else
constexpr long VOUT_DELTA_PROBE = 0;
#endif
template <int OOP> struct EpiResT {
    static constexpr bool PERM = true, AFTER_DRAIN = false;
    half_t* v; const f32x2v* stats; const float* lnG; const float* lnB; const float* modL; int gate_k; float coef; int do_ln;
    __device__ __forceinline__ void operator()(const f32x4 (&acc)[2][2][4][2], const Unit& u, int wr, int wc, int fr, int fq) const {
        const int cond = (u.pm < 16) ? 8 : ((u.pm - 16) >> 4);
        const float* gate = modL + (size_t)cond * 9216 + gate_k * 1024;
        const int row0 = u.pm * 256 + wr * 64 + fr, col0 = u.pn * 256 + wc * 32 + 8 * fq;
#pragma unroll
        for (int bj = 0; bj < 2; ++bj) {
            const int col = col0 + bj * 128;
            const f32x4 g0 = *(const f32x4*)(gate + col) * coef, g1 = *(const f32x4*)(gate + col + 4) * coef;
            f32x4 G0 = {1.f, 1.f, 1.f, 1.f}, G1 = G0, B0 = {0.f, 0.f, 0.f, 0.f}, B1 = B0;
            if (do_ln) { G0 = *(const f32x4*)(lnG + col); G1 = *(const f32x4*)(lnG + col + 4); B0 = *(const f32x4*)(lnB + col); B1 = *(const f32x4*)(lnB + col + 4); }
#pragma unroll
            for (int ai = 0; ai < 2; ++ai) {
                h8 hv[4]; f32x2v st[4];
#pragma unroll
                for (int m = 0; m < 4; ++m) {
                    const int row = row0 + ai * 128 + m * 16;
                    hv[m] = *(const h8*)(v + (size_t)row * D + col);
                    f32x2v t; t.x = 0.f; t.y = 1.f; if (do_ln) t = stats[row]; st[m] = t;
                }
                asm volatile("" ::: "memory");
#pragma unroll
                for (int m = 0; m < 4; ++m) {
                    const h8 h = hv[m];
                    f32x4 x0 = {(float)h[0], (float)h[1], (float)h[2], (float)h[3]}, x1 = {(float)h[4], (float)h[5], (float)h[6], (float)h[7]};
                    const f32x2v s2 = st[m];
                    x0 = (x0 - s2.x) * s2.y * G0 + B0; x1 = (x1 - s2.x) * s2.y * G1 + B1;
                    x0 = ALPHA * x0 + g0 * acc[ai][bj][m][0]; x1 = ALPHA * x1 + g1 * acc[ai][bj][m][1];
                    h8 o; o[0] = (half_t)x0[0]; o[1] = (half_t)x0[1]; o[2] = (half_t)x0[2]; o[3] = (half_t)x0[3]; o[4] = (half_t)x1[0]; o[5] = (half_t)x1[1]; o[6] = (half_t)x1[2]; o[7] = (half_t)x1[3];
                    *(h8*)(v + (size_t)(row0 + ai * 128 + m * 16) * D + col + (OOP ? VOUT_DELTA_PROBE : 0)) = o;
                }
                asm volatile("" ::: "memory");
            }
        }
    }
};

struct EpiMixIn {
    static constexpr bool PERM = true, AFTER_DRAIN = false;
    bf16_t *z, *ptl, *ptc;
    __device__ __forceinline__ void operator()(const f32x4 (&acc)[2][2][4][2], const Unit& u, int wr, int wc, int fr, int fq) const {
        const int row0 = u.pm * 256 + wr * 64 + fr;
        if (u.pn == 1 || u.pn == 2) {
            const int cs = u.pn - 1;
#pragma unroll
            for (int ai = 0; ai < 2; ++ai)
#pragma unroll
                for (int m = 0; m < 4; ++m) {
                    const int row = row0 + ai * 128 + m * 16;
                    bf16_t* base; size_t stride;
                    if (row < MCTX) { const int b = row >> 8, n = row & 255; base = ptc + ((size_t)(b * 256)) * 512 + cs * 256 + n; stride = 512; }
                    else { const int r2 = row - MCTX, b = r2 >> 12, n = r2 & 4095; base = ptl + ((size_t)(b * 256)) * 8192 + cs * 4096 + n; stride = 8192; }
#pragma unroll
                    for (int bj = 0; bj < 2; ++bj)
#pragma unroll
                        for (int n = 0; n < 2; ++n)
#pragma unroll
                            for (int j = 0; j < 4; ++j) { const int hd = bj * 128 + wc * 32 + 8 * fq + 4 * n + j; base[(size_t)hd * stride] = f2bf(acc[ai][bj][m][n][j]); }
                    asm volatile("" ::: "memory");
                }
        } else {
            const int zc0 = (u.pn == 0) ? 0 : (u.pn == 3 ? 256 : (u.pn == 4 ? 512 : 768));
#pragma unroll
            for (int ai = 0; ai < 2; ++ai)
#pragma unroll
                for (int m = 0; m < 4; ++m) {
                    const int row = row0 + ai * 128 + m * 16;
#pragma unroll
                    for (int bj = 0; bj < 2; ++bj) {
                        const f32x4 a0 = acc[ai][bj][m][0], a1 = acc[ai][bj][m][1];
                        u32x4 w; w.x = cvt_pk_bf16(a0[0], a0[1]); w.y = cvt_pk_bf16(a0[2], a0[3]); w.z = cvt_pk_bf16(a1[0], a1[1]); w.w = cvt_pk_bf16(a1[2], a1[3]);
                        *(u32x4*)(z + (size_t)row * D + zc0 + bj * 128 + wc * 32 + 8 * fq) = w;
                    }
                    asm volatile("" ::: "memory");
                }
        }
    }
};

struct EpiDft {
    static constexpr bool PERM = true, AFTER_DRAIN = false;
    bf16_t* ycat; int rowbase, seqlen;
    __device__ __forceinline__ void operator()(const f32x4 (&acc)[2][2][4][2], const Unit& u, int wr, int wc, int fr, int fq) const {
        const int row0 = rowbase + u.pn * seqlen + u.pm * 256 + wr * 64 + fr;
#pragma unroll
        for (int ai = 0; ai < 2; ++ai)
#pragma unroll
            for (int m = 0; m < 4; ++m) {
                const int row = row0 + ai * 128 + m * 16;
#pragma unroll
                for (int bj = 0; bj < 2; ++bj) {
                    const f32x4 a0 = acc[ai][bj][m][0], a1 = acc[ai][bj][m][1];
                    u32x4 w; w.x = cvt_pk_bf16(a0[0], a0[1]); w.y = cvt_pk_bf16(a0[2], a0[3]); w.z = cvt_pk_bf16(a1[0], a1[1]); w.w = cvt_pk_bf16(a1[2], a1[3]);
                    *(u32x4*)(ycat + (size_t)row * D + 256 + bj * 128 + wc * 32 + 8 * fq) = w;
                }
            }
    }
};

struct EpiGlu {
    static constexpr bool PERM = true, AFTER_DRAIN = false;
    const bf16_t* ya; bf16_t* ycat; const float* bias;
    __device__ __forceinline__ void operator()(const f32x4 (&acc)[2][2][4][2], const Unit& u, int wr, int wc, int fr, int fq) const {
        const int row0 = u.pm * 256 + wr * 64 + fr;
#pragma unroll
        for (int bj = 0; bj < 2; ++bj) {
            const int lc = bj * 128 + wc * 32 + 8 * fq;
            const f32x4 b0 = *(const f32x4*)(bias + lc), b1 = *(const f32x4*)(bias + lc + 4);
#pragma unroll
            for (int ai = 0; ai < 2; ++ai) {
                u32x4 yv[4];
#pragma unroll
                for (int m = 0; m < 4; ++m) yv[m] = *(const u32x4*)(ya + (size_t)(row0 + ai * 128 + m * 16) * 256 + lc);
                asm volatile("" ::: "memory");
#pragma unroll
                for (int m = 0; m < 4; ++m) {
                    const int row = row0 + ai * 128 + m * 16;
                    const u32x4 y4 = yv[m];
                    const f32x4 a0 = acc[ai][bj][m][0] + b0, a1 = acc[ai][bj][m][1] + b1;
                    float o[8];
                    o[0] = bflo(y4.x) * sigmoidf_(a0[0]); o[1] = bfhi(y4.x) * sigmoidf_(a0[1]); o[2] = bflo(y4.y) * sigmoidf_(a0[2]); o[3] = bfhi(y4.y) * sigmoidf_(a0[3]);
                    o[4] = bflo(y4.z) * sigmoidf_(a1[0]); o[5] = bfhi(y4.z) * sigmoidf_(a1[1]); o[6] = bflo(y4.w) * sigmoidf_(a1[2]); o[7] = bfhi(y4.w) * sigmoidf_(a1[3]);
                    u32x4 w; w.x = cvt_pk_bf16(o[0], o[1]); w.y = cvt_pk_bf16(o[2], o[3]); w.z = cvt_pk_bf16(o[4], o[5]); w.w = cvt_pk_bf16(o[6], o[7]);
                    *(u32x4*)(ycat + (size_t)row * D + lc) = w;
                }
                asm volatile("" ::: "memory");
            }
        }
    }
};

__device__ __forceinline__ void s5_unit(const Ctx& Xin, LAS unsigned char* hl, int layer, int dir, int g, int ph, int rowA, int rowB, int L, int bA, int bB, bool latent) {
    OPAQUE_CTX(X, Xin);
    const int lane = otid() & 63, r = lane & 31, half = lane >> 5;
    const int ldg = (layer * 2 + dir) * 16 + g;
    bf16x8 bfr[2], cfr[4];
#pragma unroll
    for (int i = 0; i < 2; ++i) bfr[i] = *(const bf16x8*)(X.s5b() + ((size_t)(ldg * 128 + (2 * ph + i) * 32 + r)) * 16 + 8 * half);
#pragma unroll
    for (int s = 0; s < 4; ++s) {
        u32x4 c = {0u, 0u, 0u, 0u};
        if (r < 16) {
            const bf16_t* cp = X.s5c() + ((size_t)(ldg * 16 + r)) * 128 + 4 * (8 * s + 4 * half) + 2 * ph;
            c.x = *(const unsigned*)(cp); c.y = *(const unsigned*)(cp + 4); c.z = *(const unsigned*)(cp + 8); c.w = *(const unsigned*)(cp + 12);
        }
        cfr[s] = __builtin_bit_cast(bf16x8, c);
    }
    const f32x2v a0 = X.s5a()[ldg * 64 + r + 32 * ph];
    float s0r = 0.f, s0i = 0.f;
    const int myb = half ? bB : bA;
    const size_t sidx = ((size_t)((myb * 4 + layer) * 2 + dir) * 16 + g) * 64 + r + 32 * ph;
    if (latent) { s0r = X.in[3][sidx]; s0i = X.in[4][sidx]; }
    const int hs = (r >> 2) & 1, jA = (r & 3) + 4 * (r >> 3);
    const bf16_t* ubase = X.z() + (size_t)((hs ? rowB : rowA) + (dir ? 15 - jA : jA)) * D + g * 16 + 8 * half;
    LAS unsigned char* ys = hl + 4608;
    const int srho = lane >> 1, spart = lane & 1, sseq = (srho >> 2) & 1, sj = (srho & 3) + 4 * (srho >> 3);
    bf16_t* ybase = X.ypart(dir * 2 + ph) + (size_t)((sseq ? rowB : rowA) + (dir ? 15 - sj : sj)) * 256 + g * 16 + spart * 8;
    const int ngrp = L >> 4;
    bf16x8 afr = *(const bf16x8*)(ubase + (size_t)(dir ? (L - 16) : 0) * D);
    asm volatile("" : "+v"(afr));
    for (int it = 0; it < ngrp; ++it) {
        const int t0 = dir ? (L - 16 * (it + 1)) : (16 * it);
        const int tn = (it + 1 < ngrp) ? (dir ? (t0 - 16) : (t0 + 16)) : t0;
        const bf16x8 anext = *(const bf16x8*)(ubase + (size_t)tn * D);
        const f32x16 zero16 = {0.f, 0.f, 0.f, 0.f, 0.f, 0.f, 0.f, 0.f, 0.f, 0.f, 0.f, 0.f, 0.f, 0.f, 0.f, 0.f};
        const f32x16 bu0 = __builtin_amdgcn_mfma_f32_32x32x16_bf16(afr, bfr[0], zero16, 0, 0, 0);
        const f32x16 bu1 = __builtin_amdgcn_mfma_f32_32x32x16_bf16(afr, bfr[1], zero16, 0, 0, 0);
#pragma unroll
        for (int j = 0; j < 16; ++j) {
            const float n0r = __builtin_fmaf(a0.x, s0r, __builtin_fmaf(-a0.y, s0i, bu0[j])), n0i = __builtin_fmaf(a0.x, s0i, __builtin_fmaf(a0.y, s0r, bu1[j]));
            s0r = n0r; s0i = n0i;
            const int rho = (j & 3) + 8 * (j >> 2);
            *(LAS unsigned*)(hl + (rho + 4 * half) * 144 + r * 4) = cvt_pk_bf16(s0r, s0i);
        }
        asm volatile("s_waitcnt lgkmcnt(0)" ::: "memory");
        f32x16 y0 = zero16, y1 = zero16;
#pragma unroll
        for (int s = 0; s < 4; s += 2) {
            const bf16x8 ha = *(const LAS bf16x8*)(hl + r * 144 + (16 * s + 8 * half) * 2);
            const bf16x8 hb = *(const LAS bf16x8*)(hl + r * 144 + (16 * (s + 1) + 8 * half) * 2);
            y0 = __builtin_amdgcn_mfma_f32_32x32x16_bf16(ha, cfr[s], y0, 0, 0, 0);
            y1 = __builtin_amdgcn_mfma_f32_32x32x16_bf16(hb, cfr[s + 1], y1, 0, 0, 0);
        }
        if (r < 16) {
#pragma unroll
            for (int j = 0; j < 16; ++j) { const int rho = (j & 3) + 8 * (j >> 2);
                *(LAS bf16_t*)(ys + (rho + 4 * half) * 32 + r * 2) = f2bf(y0[j] + y1[j]); }
        }
        asm volatile("s_waitcnt lgkmcnt(0)" ::: "memory");
        const u32x4 yv = *(const LAS u32x4*)(ys + srho * 32 + spart * 16);
        *(u32x4*)(ybase + (size_t)t0 * 256) = yv;
        asm volatile("s_waitcnt lgkmcnt(0)" ::: "memory");
        afr = anext;
    }
    if (!latent) { X.out[OUT_RE + sidx] = s0r; X.out[OUT_IM + sidx] = s0i; }
}

__device__ __forceinline__ void sgu_prep_item(const Ctx& Xin, int witem) {
    OPAQUE_CTX(X, Xin);
    const int lane = otid() & 63, g = witem & 3, row = (witem >> 2) * 64 + lane;
    const bf16_t* zp = X.z() + (size_t)row * D + 768 + g * 64;
    float x[64];
#pragma unroll
    for (int q = 0; q < 8; ++q) {
        const u32x4 w = *(const u32x4*)(zp + q * 8);
        x[q * 8 + 0] = geluf_(bflo(w.x)); x[q * 8 + 1] = geluf_(bfhi(w.x)); x[q * 8 + 2] = geluf_(bflo(w.y)); x[q * 8 + 3] = geluf_(bfhi(w.y));
        x[q * 8 + 4] = geluf_(bflo(w.z)); x[q * 8 + 5] = geluf_(bfhi(w.z)); x[q * 8 + 6] = geluf_(bflo(w.w)); x[q * 8 + 7] = geluf_(bfhi(w.w));
    }
    float s = 0.f;
#pragma unroll
    for (int c = 0; c < 64; ++c) s += x[c];
    const float mean = s * (1.0f / 64.0f);
    float q2 = 0.f;
#pragma unroll
    for (int c = 0; c < 64; ++c) { const float d = x[c] - mean; q2 += d * d; }
    const float rstd = rsqrtf(q2 * (1.0f / 64.0f) + LN_EPS);
    bf16_t* dst = X.vnt() + ((size_t)((row >> 7) * 4 + g)) * 64 * 128 + (row & 127);
#pragma unroll
    for (int c = 0; c < 64; ++c) dst[c * 128] = f2bf((x[c] - mean) * rstd);
}

__device__ __forceinline__ void sgu_chunk_wave(const Ctx& Xin, int layer, int chunk) {
#pragma nounroll
    for (int q = 0; q < 8; ++q) sgu_prep_item(Xin, (((chunk * 2 + (q >> 2)) << 2) | (q & 3)));
    asm volatile("s_waitcnt vmcnt(0)" ::: "memory");
    OPAQUE_CTX(X, Xin);
    const int lane = otid() & 63, r = lane & 31, half = lane >> 5;
#pragma nounroll
    for (int gt = 0; gt < 16; ++gt) {
        const int g = gt >> 2, tr = gt & 3;
        const bf16_t* Ap = X.wsgu() + ((size_t)((layer * 4 + g) * 128 + tr * 32 + r)) * 128 + 8 * half;
        const float* sb = X.in[27] + (layer * 4 + g) * 128;
        bf16x8 af[8];
#pragma unroll
        for (int s = 0; s < 8; ++s) af[s] = *(const bf16x8*)(Ap + 16 * s);
#pragma unroll
        for (int tc = 0; tc < 2; ++tc) {
            const bf16_t* Bp = X.vnt() + ((size_t)((chunk * 4 + g) * 64 + tc * 32 + r)) * 128 + 8 * half;
            const int c = tc * 32 + r;
            bf16_t uu[16]; float bs[16];
#pragma unroll
            for (int j = 0; j < 16; ++j) {
                const int t = tr * 32 + (j & 3) + 8 * (j >> 2) + 4 * half, row = chunk * 128 + t;
                uu[j] = X.z()[(size_t)row * D + 512 + g * 64 + c]; bs[j] = sb[t];
            }
            f32x16 acc = {0.f, 0.f, 0.f, 0.f, 0.f, 0.f, 0.f, 0.f, 0.f, 0.f, 0.f, 0.f, 0.f, 0.f, 0.f, 0.f};
#pragma unroll
            for (int s = 0; s < 8; ++s) {
                const bf16x8 b = *(const bf16x8*)(Bp + 16 * s);
                acc = __builtin_amdgcn_mfma_f32_32x32x16_bf16(af[s], b, acc, 0, 0, 0);
            }
            asm volatile("" ::: "memory");
#pragma unroll
            for (int j = 0; j < 16; ++j) {
                const int t = tr * 32 + (j & 3) + 8 * (j >> 2) + 4 * half, row = chunk * 128 + t;
                X.ycat()[(size_t)row * D + 768 + g * 64 + c] = f2bf(geluf_(bf2f(uu[j])) * (acc[j] + bs[j]));
            }
            asm volatile("" ::: "memory");
        }
    }
}

__device__ __forceinline__ void phase_l7(const Ctx& Xin, int layer) {
    OPAQUE_CTX(X, Xin);
    const int tid = otid(), lane = tid & 63, wave = tid >> 6, G = gridDim.x;
    {
        const float* dsk = X.in[20] + layer * 256;
        const size_t gt = (size_t)blockIdx.x * 512 + tid, gs = (size_t)G * 512;
        const int c8h = (int)(gt & 31) * 8;
        const f32x4 d0 = *(const f32x4*)(dsk + c8h), d1 = *(const f32x4*)(dsk + c8h + 4);
        for (size_t i0 = gt; i0 < (size_t)MTOT * 32; i0 += 3 * gs) {
            u32x4 uw[3], f0[3], f1[3], b0[3], b1[3];
#pragma unroll
            for (int q = 0; q < 3; ++q) {
                const size_t i = i0 + (size_t)q * gs;
                if (i < (size_t)MTOT * 32) {
                    const int row = (int)(i >> 5), c8 = (int)(i & 31) * 8;
                    uw[q] = *(const u32x4*)(X.z() + (size_t)row * D + c8);
                    f0[q] = *(const u32x4*)(X.ypart(0) + (size_t)row * 256 + c8); f1[q] = *(const u32x4*)(X.ypart(1) + (size_t)row * 256 + c8);
                    b0[q] = *(const u32x4*)(X.ypart(2) + (size_t)row * 256 + c8); b1[q] = *(const u32x4*)(X.ypart(3) + (size_t)row * 256 + c8);
                }
            }
            asm volatile("" ::: "memory");
#pragma unroll
            for (int q = 0; q < 3; ++q) {
                const size_t i = i0 + (size_t)q * gs;
                if (i < (size_t)MTOT * 32) {
                    const int row = (int)(i >> 5), c8 = (int)(i & 31) * 8;
                    const u32x4 U = uw[q], F0 = f0[q], F1 = f1[q], B0 = b0[q], B1 = b1[q];
                    const f32x4 plo = {bflo(F0.x) + bflo(F1.x) + bflo(B0.x) + bflo(B1.x), bfhi(F0.x) + bfhi(F1.x) + bfhi(B0.x) + bfhi(B1.x), bflo(F0.y) + bflo(F1.y) + bflo(B0.y) + bflo(B1.y), bfhi(F0.y) + bfhi(F1.y) + bfhi(B0.y) + bfhi(B1.y)};
                    const f32x4 phi = {bflo(F0.z) + bflo(F1.z) + bflo(B0.z) + bflo(B1.z), bfhi(F0.z) + bfhi(F1.z) + bfhi(B0.z) + bfhi(B1.z), bflo(F0.w) + bflo(F1.w) + bflo(B0.w) + bflo(B1.w), bfhi(F0.w) + bfhi(F1.w) + bfhi(B0.w) + bfhi(B1.w)};
                    float o[8];
                    o[0] = geluf_(bflo(U.x) * d0[0] + plo[0]); o[1] = geluf_(bfhi(U.x) * d0[1] + plo[1]);
                    o[2] = geluf_(bflo(U.y) * d0[2] + plo[2]); o[3] = geluf_(bfhi(U.y) * d0[3] + plo[3]);
                    o[4] = geluf_(bflo(U.z) * d1[0] + phi[0]); o[5] = geluf_(bfhi(U.z) * d1[1] + phi[1]);
                    o[6] = geluf_(bflo(U.w) * d1[2] + phi[2]); o[7] = geluf_(bfhi(U.w) * d1[3] + phi[3]);
                    u32x4 w; w.x = cvt_pk_bf16(o[0], o[1]); w.y = cvt_pk_bf16(o[2], o[3]); w.z = cvt_pk_bf16(o[4], o[5]); w.w = cvt_pk_bf16(o[6], o[7]);
                    *(u32x4*)(X.ya() + (size_t)row * 256 + c8) = w;
                }
            }
            asm volatile("" ::: "memory");
        }
    }
}

struct FinRaw { u32x2 ya, yb, yd, qt, wq[16]; };
__device__ __forceinline__ void fin_load(const Ctx& X, int row, int lane, FinRaw& R) {
    const int c4 = 4 * lane;
    int sb, n, t;
    if (row < MCTX) { sb = row & ~255; n = 256; t = row & 255; } else { const int r2 = row - MCTX; sb = MCTX + (r2 & ~4095); n = 4096; t = r2 & 4095; }
    R.ya = *(const u32x2*)(X.ycat() + (size_t)row * D + c4);
    R.yb = *(const u32x2*)(X.ycat() + (size_t)row * D + 256 + c4);
    R.yd = *(const u32x2*)(X.ycat() + (size_t)row * D + 768 + c4);
    R.qt = *(const u32x2*)(X.z() + (size_t)row * D + 256 + c4);
    const int hw = 1 << (lane >> 4);
    const bf16_t* qb = X.z() + (size_t)sb * D + 256 + c4;
#pragma unroll
    for (int i = 0; i < 16; ++i) { int sidx = t - hw + i; sidx = sidx < 0 ? 0 : (sidx > n - 1 ? n - 1 : sidx); R.wq[i] = *(const u32x2*)(qb + (size_t)sidx * D); }
}
__device__ __forceinline__ f32x4 up4(u32x2 w) { return (f32x4){bflo(w.x), bfhi(w.x), bflo(w.y), bfhi(w.y)}; }
__device__ __forceinline__ void fin_row(const Ctx& X, int row, int lane, const FinRaw& R, const f32x4 (&png4)[4], f32x4 ps) {
    const int c4 = 4 * lane;
    int n, t;
    if (row < MCTX) { n = 256; t = row & 255; } else { n = 4096; t = (row - MCTX) & 4095; }
    const int hw = 1 << (lane >> 4);
    const int lo = (t - hw) < 0 ? 0 : (t - hw), hi = (t + hw) > n ? n : (t + hw);
    f32x4 y[4];
    y[0] = up4(R.ya); y[1] = up4(R.yb); y[3] = up4(R.yd);
    f32x4 sum = {0.f, 0.f, 0.f, 0.f};
#pragma unroll
    for (int i = 0; i < 16; ++i) { const int sidx = t - hw + i; const float m = (i < 2 * hw && sidx >= 0 && sidx < n) ? 1.0f : 0.0f; sum += m * up4(R.wq[i]); }
    y[2] = (sum * (1.0f / (float)(hi - lo)) - up4(R.qt)) * ps;
#pragma unroll
    for (int gq = 0; gq < 4; ++gq) {
        const f32x4 v = y[gq];
        const float ss = wave_sum((v[0] * v[0] + v[1] * v[1]) + (v[2] * v[2] + v[3] * v[3]));
        const float sc = rsqrtf(ss * (1.0f / 256.0f) + LN_EPS);
        const f32x4 o = v * sc * png4[gq];
        u32x2 w; w.x = cvt_pk_bf16(o[0], o[1]); w.y = cvt_pk_bf16(o[2], o[3]);
        *(u32x2*)(X.h() + (size_t)row * D + gq * 256 + c4) = w;
    }
}
__device__ __forceinline__ void phase_finalize(const Ctx& Xin, int layer) {
    OPAQUE_CTX(X, Xin);
    const int tid_ = otid(), lane = tid_ & 63, gw = blockIdx.x * 8 + (tid_ >> 6), nw = gridDim.x * 8;
    const float* png = X.in[12] + layer * 1024;
    const f32x4 ps = *(const f32x4*)(X.in[25] + layer * 256 + 4 * lane);
    f32x4 png4[4];
#pragma unroll
    for (int gq = 0; gq < 4; ++gq) png4[gq] = *(const f32x4*)(png + gq * 256 + 4 * lane);
    for (int row = gw; row < MTOT; row += 2 * nw) {
        const int rowb = row + nw;
        FinRaw Ra, Rb;
        fin_load(X, row, lane, Ra);
        if (rowb < MTOT) fin_load(X, rowb, lane, Rb);
        fin_row(X, row, lane, Ra, png4, ps);
        if (rowb < MTOT) fin_row(X, rowb, lane, Rb, png4, ps);
    }
}

__global__ void __launch_bounds__(512, 2) fwd_megakernel(Args a) {
    extern __shared__ __attribute__((aligned(16))) unsigned char lds_raw[];
    LAS unsigned char* lds = (LAS unsigned char*)lds_raw;
    cg::grid_group grid = cg::this_grid();
    Ctx X0; X0.out = a.out; X0.ws = a.ws;
    const int G = gridDim.x, bid = blockIdx.x;

#ifndef PHMASK
#define PHMASK 0xFFFF
#endif
#ifndef DUPMASK
#define DUPMASK 0
#endif
#define PH(k) _Pragma("nounroll") for (int rep_ = 0; rep_ < (((DUPMASK) >> (k)) & 1) + 1; ++rep_)
    if (threadIdx.x < 4) ((LAS unsigned*)(lds + 131072))[threadIdx.x] = 0u;
    if (bid == 0) { unsigned* bw = (unsigned*)(a.ws + WS_BAR); for (int i = threadIdx.x; i < XCD_BAR_WORDS; i += 512) bw[i] = 0u; }
    __syncthreads();
    PH(0) phase0(X0, lds);
    grid.sync();
    const XcdBarrier xbar = xcd_barrier_post((unsigned*)(a.ws + WS_BAR), (volatile LAS unsigned*)(lds + 131072));
#define GSYNC() xcd_barrier(xbar)

    for (int sl = 0; sl < 12; ++sl) {
        const int layer = sl / 3, sub = sl % 3;
        const int do_ln = sl > 0;
        OPAQUE_CTX(X, X0);
        const float* pG = X.in[28] + (size_t)(do_ln ? sl - 1 : 0) * D;
        const float* pB = X.in[29] + (size_t)(do_ln ? sl - 1 : 0) * D;
        const float* modL = X.mod() + (size_t)layer * 9 * 9216;
        PH(1) phase_lnmod(X0, layer, sub, do_ln, pG, pB);
        GSYNC();
        if (sub != 1) {
            const int li = layer * 2 + (sub >> 1);
            PH(2) {
                pg8::Gemm g{X.h(), X.wfi() + (size_t)li * NFI * D, MTOT, NFI, D}; pg8::StaticOrder S; S.init(MTOT, NFI, G, bid);
                EpiSwiGLU E{X.act()};
                pg8::gemm_phase<EpiSwiGLU, pg8::StaticOrder>(lds, g, S, E, nullptr);
            }
            GSYNC();
            PH(3) {
                pg8::Gemm g{X.act(), X.wfo() + (size_t)li * D * DFF, MTOT, D, DFF}; pg8::StaticOrder S; S.init(MTOT, D, G, bid);
                EpiResT<1> E{X.v(), X.stats(), pG, pB, modL, sub * 3 + 2, 0.5f, do_ln};
                pg8::gemm_phase<EpiResT<1>, pg8::StaticOrder>(lds, g, S, E, nullptr);
            }
            GSYNC();
#ifdef PROBE_FFNOUT
            { const u32x4* src = (const u32x4*)(X.ws + WS_ACT + (size_t)MTOT * DFF * 2); u32x4* dst = (u32x4*)X.v();
              for (size_t i = (size_t)bid * 512 + otid(); i < (size_t)MTOT * D / 8; i += (size_t)G * 512) dst[i] = src[i]; }
            GSYNC();
#endif
        } else {
            PH(4) {
                pg8::Gemm g{X.h(), X.wmi() + (size_t)layer * NMI * D, MTOT, NMI, D}; pg8::StaticOrder S; S.init(MTOT, NMI, G, bid);
                EpiMixIn E{X.z(), X.ptl(), X.ptc()};
                pg8::gemm_phase<EpiMixIn, pg8::StaticOrder>(lds, g, S, E, nullptr);
            }
            GSYNC();
            {
                const int nd = G >> 1, ns = G - nd;
                if (bid < nd) { PH(5) {
#pragma nounroll
                    for (int pass = 0; pass < 2; ++pass) {
                        pg8::Gemm g; pg8::StaticOrder S; EpiDft E;
                        if (pass == 0) { g = pg8::Gemm{X.dl(), X.ptl(), 4096, 2048, 8192}; S.init(4096, 2048, nd, bid); E = EpiDft{X.ycat(), MCTX, 4096}; }
                        else { g = pg8::Gemm{X.dc(), X.ptc(), 256, 4096, 512}; S.init(256, 4096, nd, bid); E = EpiDft{X.ycat(), 0, 256}; }
                        pg8::gemm_phase<EpiDft, pg8::StaticOrder>(lds, g, S, E, nullptr);
                    }
                } } else {
                    const int c = bid - nd, wave = otid() >> 6;
                    LAS unsigned char* hl = lds + wave * 5632;
                    PH(6) if (wave < 2) {
                        for (int u = c * 2 + wave; u < 256; u += ns * 2) { const int ph = u & 1, g = (u >> 1) & 15, dir = (u >> 5) & 1, bp = u >> 6;
                            s5_unit(X0, hl, layer, dir, g, ph, MCTX + bp * 4096, MCTX + (bp + 4) * 4096, 4096, bp, bp + 4, true); }
                    } else if (wave < 4) {
                        for (int u = c * 2 + (wave - 2); u < 512; u += ns * 2) { const int ph = u & 1, g = (u >> 1) & 15, dir = (u >> 5) & 1, bp = u >> 6;
                            s5_unit(X0, hl, layer, dir, g, ph, bp * 256, (bp + 8) * 256, 256, bp, bp + 8, false); }
                    } else {
                        const int slot = (wave >= 6) ? (c * 2 + (wave - 6)) : (ns * 2 + c * 2 + (wave - 4));
                        for (int ch = slot; ch < MTOT / 128; ch += ns * 4) sgu_chunk_wave(X0, layer, ch);
                        if (wave >= 6 && layer < 3) {
                            LAS float* wtile = (LAS float*)(lds + 32768 + (wave - 6) * 16640);
                            for (int j = c * 2 + (wave - 6); j < 4688; j += ns * 2) wave_tconv(X0, wtile, t1_map(layer + 1, j));
                        }
                    }
                }
            }
            GSYNC();
            PH(7) phase_l7(X0, layer);
            GSYNC();
            PH(8) {
                pg8::Gemm g{X.ya(), X.wglu() + (size_t)layer * 65536, MTOT, 256, 256 + (G >> 20)}; pg8::StaticOrder S; S.init(MTOT, 256, G, bid);
                EpiGlu E{X.ya(), X.ycat(), X.in[22] + layer * 256};
                pg8::gemm_phase<EpiGlu, pg8::StaticOrder>(lds, g, S, E, nullptr);
            }
            GSYNC();
            PH(9) phase_finalize(X0, layer);
            GSYNC();
            PH(10) {
                pg8::Gemm g{X.h(), X.wmo() + (size_t)layer * D * D, MTOT, D, D}; pg8::StaticOrder S; S.init(MTOT, D, G, bid);
                EpiResT<0> E{X.v(), X.stats(), pG, pB, modL, 5, 1.0f, do_ln};
                pg8::gemm_phase<EpiResT<0>, pg8::StaticOrder>(lds, g, S, E, nullptr);
            }
            GSYNC();
        }
    }
#ifdef XSYNC
#pragma nounroll
    for (int q_ = 0; q_ < XSYNC; ++q_) GSYNC();
#endif
    PH(11) phase_final_ln(X0, X0.in[28] + (size_t)11 * D, X0.in[29] + (size_t)11 * D);
}

extern "C" void kernel_launch(void* const* d_in, const int* in_sizes, int n_in, void* d_out, int out_size,
                              void* d_ws, size_t ws_size, hipStream_t stream) {
    static int grid_blocks = 0;
    if (!grid_blocks) {
        if (n_in != 30 || out_size != OUT_TOTAL || ws_size < WS_END) {
            fprintf(stderr, "kernel_launch: unexpected shapes: n_in %d out %d (want %d) ws %zu (need %zu)\n", n_in, out_size, OUT_TOTAL, ws_size, (size_t)WS_END);
            grid_blocks = -1; return;
        }
        int dev = 0, cus = 0, per_cu = 0;
        if (hipGetDevice(&dev) != hipSuccess || hipDeviceGetAttribute(&cus, hipDeviceAttributeMultiprocessorCount, dev) != hipSuccess) { grid_blocks = -1; return; }
        if (hipFuncSetAttribute((const void*)fwd_megakernel, hipFuncAttributeMaxDynamicSharedMemorySize, LDS_BYTES) != hipSuccess) { fprintf(stderr, "hipFuncSetAttribute failed\n"); grid_blocks = -1; return; }
        if (hipOccupancyMaxActiveBlocksPerMultiprocessor(&per_cu, (const void*)fwd_megakernel, 512, LDS_BYTES) != hipSuccess || per_cu < 1) {
            fprintf(stderr, "kernel_launch: occupancy query says %d blocks per CU\n", per_cu); (void)hipGetLastError(); }
        grid_blocks = cus;
    }
    if (grid_blocks < 0) return;
    Args a{};
    for (int i = 0; i < 30; ++i) a.in[i] = (const float*)d_in[i];
    a.out = (float*)d_out; a.ws = (unsigned char*)d_ws;
    void* args[] = {&a};
    hipError_t e = hipLaunchCooperativeKernel((void*)fwd_megakernel, dim3(grid_blocks), dim3(512), args, LDS_BYTES, stream);
    if (e != hipSuccess) fprintf(stderr, "cooperative launch failed: %s (grid %d)\n", hipGetErrorString(e), grid_blocks);
}
```

```cpp
#include <hip/hip_runtime.h>
#include <hip/hip_cooperative_groups.h>
#include <cstdio>
namespace cg = cooperative_groups;
namespace pg8 {
#define PG8_LAS __attribute__((address_space(3)))
typedef unsigned short bf16_t;
typedef short bf16x8 __attribute__((ext_vector_type(8)));
typedef float f32x4 __attribute__((ext_vector_type(4)));
typedef unsigned u32x4 __attribute__((ext_vector_type(4)));
constexpr int BM = 256, BK = 64, HALF = 128, HTB = HALF * BK * 2  , STAGE_BYTES = 8 * HTB, NXCD = 8, WGM = 8;

__host__ __device__ __forceinline__ int lds_byte(int r, int c) { const int st = (r >> 4) * 2 + (c >> 5), rr = r & 15, cc = c & 31, ob = rr * 64 + cc * 2; return st * 1024 + (ob ^ (((ob >> 9) & 1) << 5)); }
__host__ __device__ __forceinline__ void stage_rc(int b, int& R, int& C) { const int st = b / 1024, sb = b % 1024, swz = sb ^ (((sb >> 9) & 1) << 5); R = (st >> 1) * 16 + swz / 64; C = (st & 1) * 32 + (swz % 64) / 2; }
__host__ __device__ __forceinline__ int perm32(int rho) { const int n = rho >> 4, i = rho & 15; return 8 * (i >> 2) + 4 * n + (i & 3); }

struct Unit { int pm, pn; };
struct Gemm { const bf16_t* A; const bf16_t* Bt; int M, N, K; };

struct StaticOrder {
    int nM, nN, nwg, G, c;
    __host__ __device__ void init(int M, int N, int G_, int c_) { nM = M / BM; nN = N / BM; nwg = nM * nN; G = G_; c = c_; }
    __host__ __device__ bool next(int i, Unit& u) const {
        const long L = (long)i * G + c; if (L >= nwg) return false;
        int wgid = (int)L; { const int q = nwg / NXCD, r = nwg % NXCD, xcd = wgid % NXCD, off = wgid / NXCD; wgid = (xcd < r ? xcd * (q + 1) : r * (q + 1) + (xcd - r) * q) + off; }
        const int nig = WGM * nN, gid = wgid / nig, fm = gid * WGM, gsz = (nM - fm) < WGM ? (nM - fm) : WGM;
        u.pm = fm + ((wgid % nig) % gsz); u.pn = (wgid % nig) / gsz; return true;
    }
    __device__ __forceinline__ void a_ready(const Unit&) const {}
    __device__ __forceinline__ void done(const Unit&) const {}
};
__device__ __forceinline__ unsigned cvt_pk_bf16(float lo, float hi) { unsigned r; asm volatile("v_cvt_pk_bf16_f32 %0, %1, %2" : "=v"(r) : "v"(lo), "v"(hi)); return r; }
typedef float f32x2 __attribute__((ext_vector_type(2)));
template <class Epi, class Sched, bool STAMP = false>
__device__ __forceinline__ void gemm_phase(PG8_LAS unsigned char* lds, const Gemm g, const Sched& S, const Epi& E, unsigned long long* stamps) {
    int tid_o = threadIdx.x; asm volatile("" : "+v"(tid_o));
    const int tid = tid_o, wid = __builtin_amdgcn_readfirstlane(tid >> 6), lane = tid & 63, wr = wid >> 2, wc = wid & 3, fr = lane & 15, fq = lane >> 4;
    const int K = g.K, nt = K / BK;
    int ts_lo = 0, ts_hi = 0, nts = 0; const unsigned long long rt_entry = STAMP ? (unsigned long long)wall_clock64() : 0ull;
#define PG8_STAMP() do { if (STAMP && wid == 0 && nts < 64) { const unsigned long long _c = (unsigned long long)clock64(); \
        ts_lo = (lane == nts) ? (int)(unsigned)_c : ts_lo; ts_hi = (lane == nts) ? (int)(unsigned)(_c >> 32) : ts_hi; ++nts; } } while (0)
    PG8_STAMP();
    unsigned voffA[2], voffB[2];
#pragma unroll
    for (int i = 0; i < 2; ++i) { int R, C; stage_rc(tid * 16 + i * 8192, R, C); const int Rb = Epi::PERM ? ((R & ~31) + perm32(R & 31)) : R;
        voffA[i] = (unsigned)(R * K + C) * 2u; voffB[i] = (unsigned)(Rb * K + C) * 2u; }
    const size_t kstep = (size_t)(BK * 2);
    const size_t hstep = (size_t)HALF * K * 2;
    const size_t tstep = 2 * hstep;
    const unsigned ldsw = (unsigned)wid * 1024u;
    const int aoff = lds_byte(wr * 64 + fr, fq * 8), boff = lds_byte(wc * 32 + fr, fq * 8);
#define PG8_SA(b, h) (((b) * 2 + (h)) * HTB)
#define PG8_SB(b, h) ((4 + (b) * 2 + (h)) * HTB)
#define PG8_STAGE(bufoff, gbase, voff) do { _Pragma("unroll") for (int _i = 0; _i < 2; ++_i) \
        __builtin_amdgcn_global_load_lds((const unsigned*)((const char*)(gbase) + (voff)[_i]), (PG8_LAS unsigned*)(lds + (bufoff) + ldsw + _i * 8192), 16, 0, 0); } while (0)
#define PG8_LDA(dst, b, h) do { _Pragma("unroll") for (int m = 0; m < 4; ++m) _Pragma("unroll") for (int k = 0; k < 2; ++k) dst[m][k] = *(const PG8_LAS bf16x8*)(lds + PG8_SA(b, h) + aoff + m * 2048 + k * 1024); } while (0)
#define PG8_LDB(dst, b, h) do { _Pragma("unroll") for (int n = 0; n < 2; ++n) _Pragma("unroll") for (int k = 0; k < 2; ++k) dst[n][k] = *(const PG8_LAS bf16x8*)(lds + PG8_SB(b, h) + boff + n * 2048 + k * 1024); } while (0)
#define PG8_MMA(ai, bj, At, Bt) do { __builtin_amdgcn_s_setprio(1); _Pragma("unroll") for (int m = 0; m < 4; ++m) _Pragma("unroll") for (int n = 0; n < 2; ++n) _Pragma("unroll") for (int k = 0; k < 2; ++k) \
        acc[ai][bj][m][n] = __builtin_amdgcn_mfma_f32_16x16x32_bf16(Bt[n][k], At[m][k], acc[ai][bj][m][n], 0, 0, 0); __builtin_amdgcn_s_setprio(0); } while (0)
#define PG8_WAIT_V(n) asm volatile("s_waitcnt vmcnt(" #n ")" ::: "memory")
#define PG8_WAIT_L(n) asm volatile("s_waitcnt lgkmcnt(" #n ")" ::: "memory")
#define PG8_BAR __builtin_amdgcn_s_barrier()
#define PG8_SCHED __builtin_amdgcn_sched_barrier(0)
    Unit cur, nxt; int ui = 0;
    if (!S.next(0, cur)) return;
    f32x4 acc[2][2][4][2];
#pragma unroll
    for (int a = 0; a < 2; ++a)
#pragma unroll
        for (int b = 0; b < 2; ++b)
#pragma unroll
            for (int m = 0; m < 4; ++m)
#pragma unroll
                for (int n = 0; n < 2; ++n) acc[a][b][m][n] = (f32x4){0.f, 0.f, 0.f, 0.f};
    bf16x8 At[4][2], B0[2][2], B1[2][2];
    const char* cA = (const char*)g.A + (size_t)cur.pm * tstep; const char* cB = (const char*)g.Bt + (size_t)cur.pn * tstep;
    S.a_ready(cur);
    PG8_STAGE(PG8_SB(0, 0), cB, voffB); PG8_STAGE(PG8_SA(0, 0), cA, voffA); PG8_STAGE(PG8_SB(0, 1), cB + hstep, voffB); PG8_STAGE(PG8_SA(0, 1), cA + hstep, voffA);
    if (wr == 1) PG8_BAR;
    PG8_WAIT_V(4); PG8_BAR;
    PG8_STAGE(PG8_SB(1, 0), cB + kstep, voffB); PG8_STAGE(PG8_SA(1, 0), cA + kstep, voffA); PG8_STAGE(PG8_SB(1, 1), cB + hstep + kstep, voffB);
    PG8_WAIT_V(6); PG8_BAR;
    PG8_STAMP();
    for (;;) {
        const bool has_next = S.next(ui + 1, nxt);
        const char* nA = has_next ? (const char*)g.A + (size_t)nxt.pm * tstep : cA; const char* nB = has_next ? (const char*)g.Bt + (size_t)nxt.pn * tstep : cB;
        for (int t = 0; t < nt; t += 2) {
            const bool last = (t == nt - 2);
            const char* a1 = cA + (size_t)(t + 1) * kstep;
            const char* a2 = last ? nA : cA + (size_t)(t + 2) * kstep; const char* b2 = last ? nB : cB + (size_t)(t + 2) * kstep;
            const char* a3 = a2 + kstep; const char* b3 = b2 + kstep;
            if (last && has_next) S.a_ready(nxt);
            PG8_LDB(B0, 0, 0); PG8_SCHED; PG8_LDA(At, 0, 0); PG8_STAGE(PG8_SA(1, 1), a1 + hstep, voffA);
            PG8_WAIT_L(8); PG8_BAR; PG8_WAIT_L(0); PG8_MMA(0, 0, At, B0); PG8_BAR; PG8_SCHED;
            PG8_LDB(B1, 0, 1); PG8_STAGE(PG8_SB(0, 0), b2, voffB);
            PG8_BAR; PG8_WAIT_L(0); PG8_MMA(0, 1, At, B1); PG8_BAR;
            PG8_LDA(At, 0, 1); PG8_STAGE(PG8_SA(0, 0), a2, voffA);
            PG8_BAR; PG8_WAIT_L(0); PG8_MMA(1, 0, At, B0); PG8_BAR; PG8_SCHED;
            PG8_STAGE(PG8_SB(0, 1), b2 + hstep, voffB);
            PG8_WAIT_V(6); PG8_BAR; PG8_MMA(1, 1, At, B1); PG8_BAR;
            PG8_LDB(B0, 1, 0); PG8_SCHED; PG8_LDA(At, 1, 0); PG8_STAGE(PG8_SA(0, 1), a2 + hstep, voffA);
            PG8_WAIT_L(8); PG8_BAR; PG8_WAIT_L(0); PG8_MMA(0, 0, At, B0); PG8_BAR; PG8_SCHED;
            PG8_LDB(B1, 1, 1); PG8_STAGE(PG8_SB(1, 0), b3, voffB);
            PG8_BAR; PG8_WAIT_L(0); PG8_MMA(0, 1, At, B1); PG8_BAR;
            PG8_LDA(At, 1, 1); PG8_STAGE(PG8_SA(1, 0), a3, voffA);
            PG8_BAR; PG8_WAIT_L(0); PG8_MMA(1, 0, At, B0); PG8_BAR; PG8_SCHED;
            PG8_STAGE(PG8_SB(1, 1), b3 + hstep, voffB);
            PG8_WAIT_V(6); PG8_BAR; PG8_MMA(1, 1, At, B1); PG8_BAR;
        }
        PG8_STAMP();
        if constexpr (!Epi::AFTER_DRAIN) { E(acc, cur, wr, wc, fr, fq); S.done(cur); }
        PG8_STAMP();
        if (!has_next) break;
#pragma unroll
        for (int a = 0; a < 2; ++a)
#pragma unroll
            for (int b = 0; b < 2; ++b)
#pragma unroll
                for (int m = 0; m < 4; ++m)
#pragma unroll
                    for (int n = 0; n < 2; ++n) acc[a][b][m][n] = (f32x4){0.f, 0.f, 0.f, 0.f};
        cur = nxt; cA = nA; cB = nB; ++ui;
    }
    PG8_WAIT_V(0);
    if (wr == 0) PG8_BAR;
    PG8_BAR;
    if constexpr (Epi::AFTER_DRAIN) { E.fused(acc, cur, wr, wc, fr, fq, lds, wid, lane); S.done(cur); }
    PG8_STAMP();
    if (STAMP && wid == 0) { stamps[lane] = lane < nts ? (((unsigned long long)(unsigned)ts_hi << 32) | (unsigned)ts_lo) : 0ull;
        if (lane == 62) stamps[62] = rt_entry; if (lane == 63) stamps[63] = (unsigned long long)wall_clock64(); }
#undef PG8_STAMP
#undef PG8_SA
#undef PG8_SB
#undef PG8_STAGE
#undef PG8_LDA
#undef PG8_LDB
#undef PG8_MMA
#undef PG8_WAIT_V
#undef PG8_WAIT_L
#undef PG8_BAR
#undef PG8_SCHED
}
}

using pg8::bf16_t; using pg8::bf16x8; using pg8::f32x4; using pg8::u32x4; using pg8::Unit; using pg8::cvt_pk_bf16;
typedef float f32x16 __attribute__((ext_vector_type(16)));
typedef float f32x2v __attribute__((ext_vector_type(2)));
typedef unsigned u32x2 __attribute__((ext_vector_type(2)));
typedef _Float16 half_t;
typedef _Float16 h4 __attribute__((ext_vector_type(4)));
typedef _Float16 h8 __attribute__((ext_vector_type(8)));
#define LAS PG8_LAS

#define XB_TMO      128
#define XB_XCNT(j)  (256  + 64 * (j))
#define XB_XSUB(j)  (1280 + 64 * (j))
#define XB_XGEN(j)  (2304 + 64 * (j))
#define XB_TOP      3328
#define XB_TOPGEN   3392
#define XCD_BAR_WORDS 3456
#define XB_SPIN_CAP (1u << 18)

__device__ __forceinline__ unsigned xb_ld(unsigned* p)              { return __hip_atomic_load(p, __ATOMIC_RELAXED, __HIP_MEMORY_SCOPE_AGENT); }
__device__ __forceinline__ unsigned xb_add(unsigned* p, unsigned v) { return __hip_atomic_fetch_add(p, v, __ATOMIC_RELAXED, __HIP_MEMORY_SCOPE_AGENT); }
__device__ __forceinline__ unsigned xb_xcc_id() { return (unsigned)__builtin_amdgcn_s_getreg((3 << 11) | 20) & 0xFu; }
#define XB_SPIN(cond, bar) do { unsigned _sp = 0; while (cond) { __builtin_amdgcn_s_sleep(1); \
    if ((++_sp & 255u) == 0u) { if (xb_ld(&(bar)[XB_TMO])) break; if (_sp > XB_SPIN_CAP) { atomicAdd(&(bar)[XB_TMO], 1u); break; } } } } while (0)

struct XcdBarrier {
    unsigned* bar; unsigned x;
    volatile LAS unsigned* st;
};

__device__ __forceinline__ XcdBarrier xcd_barrier_post(unsigned* bar, volatile LAS unsigned* st) {
    XcdBarrier b; b.bar = bar; b.x = xb_xcc_id(); b.st = st;
    if (threadIdx.x == 0) (void)xb_add(&bar[XB_XCNT(b.x)], 1u);
    return b;
}
__device__ __forceinline__ void xcd_barrier_complete(unsigned* bar, unsigned x, unsigned& nloc, unsigned& nx) {
    const unsigned G = gridDim.x * gridDim.y * gridDim.z;
    unsigned sum, cnt, mine, sp = 0u;
    for (;;) {
        sum = 0u; cnt = 0u; mine = 0u;
#pragma unroll
        for (unsigned j = 0; j < 16; ++j) { const unsigned c = xb_ld(&bar[XB_XCNT(j)]); sum += c; cnt += (c > 0u) ? 1u : 0u; mine = (j == x) ? c : mine; }
        if (sum == G) break;
        __builtin_amdgcn_s_sleep(1);
        if ((++sp & 255u) == 0u) { if (xb_ld(&bar[XB_TMO])) break; if (sp > XB_SPIN_CAP) { atomicAdd(&bar[XB_TMO], 1u); break; } }
    }
    nloc = mine > 0u ? mine : 1u; nx = cnt > 0u ? cnt : 1u;
}

__device__ __forceinline__ void xcd_barrier(const XcdBarrier& b) {
    asm volatile("s_waitcnt vmcnt(0)" ::: "memory");
    __syncthreads();
    if (threadIdx.x == 0) {
        unsigned* bar = b.bar;
        __builtin_amdgcn_s_waitcnt(0);
        unsigned nloc = b.st[0], nx = b.st[1];
        if (nloc == 0u) { xcd_barrier_complete(bar, b.x, nloc, nx); b.st[0] = nloc; b.st[1] = nx; }
        const unsigned old = xb_add(&bar[XB_XSUB(b.x)], 1u);
        const unsigned gen = old / nloc;
        if (old + 1u == (gen + 1u) * nloc) {
            __builtin_amdgcn_fence(__ATOMIC_RELEASE, "agent");
            asm volatile("s_waitcnt vmcnt(0)" ::: "memory");
            const unsigned og = xb_add(&bar[XB_TOP], 1u);
            const unsigned tg = og / nx;
            if (og + 1u == (tg + 1u) * nx) xb_add(&bar[XB_TOPGEN], 1u);
            else XB_SPIN(xb_ld(&bar[XB_TOPGEN]) == tg, bar);
            __builtin_amdgcn_fence(__ATOMIC_ACQUIRE, "agent");
            xb_add(&bar[XB_XGEN(b.x)], 1u);
            asm volatile("s_waitcnt vmcnt(0)" ::: "memory");
        } else {
            XB_SPIN(xb_ld(&bar[XB_XGEN(b.x)]) == gen, bar);
            __builtin_amdgcn_fence(__ATOMIC_ACQUIRE, "agent");
            asm volatile("s_waitcnt vmcnt(0)" ::: "memory");
        }
    }
    __syncthreads();
}


constexpr int D = 1024, MCTX = 4096, MTOT = 36864, DFF = 2816, NFI = 5632, NMI = 1536;
constexpr float ALPHA = 1.6817928305074290f;
constexpr float LN_EPS = 1e-5f;
constexpr int LDS_BYTES = 131072 + 16;
constexpr int OUT_RE = MTOT * D, OUT_IM = OUT_RE + 16 * 4 * 2 * 16 * 64, OUT_TOTAL = OUT_IM + 16 * 4 * 2 * 16 * 64;

constexpr size_t al256(size_t x) { return (x + 255) & ~(size_t)255; }
constexpr size_t WS_WFI = 0;
constexpr size_t WS_WFO = WS_WFI + (size_t)8 * NFI * D * 2;
constexpr size_t WS_WMI = WS_WFO + (size_t)8 * D * DFF * 2;
constexpr size_t WS_WMO = WS_WMI + (size_t)4 * NMI * D * 2;
constexpr size_t WS_WGLU = WS_WMO + (size_t)4 * D * D * 2;
constexpr size_t WS_WSGU = WS_WGLU + (size_t)4 * 256 * 256 * 2;
constexpr size_t WS_MOD = WS_WSGU + (size_t)4 * 4 * 128 * 128 * 2;
constexpr size_t WS_DL = al256(WS_MOD + (size_t)4 * 9 * 9216 * 4);
constexpr size_t WS_DC = WS_DL + (size_t)4096 * 8192 * 2;
constexpr size_t WS_S5A = WS_DC + (size_t)256 * 512 * 2;
constexpr size_t WS_S5B = WS_S5A + (size_t)128 * 64 * 8;
constexpr size_t WS_S5C = WS_S5B + (size_t)128 * 128 * 16 * 2;
constexpr size_t WS_PE = WS_S5C + (size_t)128 * 16 * 128 * 2;
constexpr size_t WS_STATS = WS_PE + (size_t)64 * 512 * 4;
constexpr size_t WS_H = WS_STATS + (size_t)MTOT * 2 * 4;
constexpr size_t WS_BIG = WS_H + (size_t)MTOT * D * 2;
constexpr size_t WS_ACT = WS_BIG;
constexpr size_t WS_Z = WS_BIG;
constexpr size_t WS_PTL = WS_Z + (size_t)MTOT * D * 2;
constexpr size_t WS_PTC = WS_PTL + (size_t)2048 * 8192 * 2;
constexpr size_t WS_YF = WS_PTC + (size_t)4096 * 512 * 2;
constexpr size_t WS_YB = WS_YF + (size_t)MTOT * 256 * 2;
constexpr size_t WS_YF1 = WS_YB + (size_t)MTOT * 256 * 2;
constexpr size_t WS_YB1 = WS_YF1 + (size_t)MTOT * 256 * 2;
constexpr size_t WS_YA = WS_YB1 + (size_t)MTOT * 256 * 2;
constexpr size_t WS_VNT = WS_YA + (size_t)MTOT * 256 * 2;
constexpr size_t WS_YCAT = WS_VNT + (size_t)1152 * 64 * 128 * 2;
constexpr size_t WS_END_MIX = WS_YCAT + (size_t)MTOT * D * 2;
constexpr size_t WS_END_ACT = WS_ACT + (size_t)MTOT * DFF * 2;
constexpr size_t WS_V = WS_END_MIX > WS_END_ACT ? WS_END_MIX : WS_END_ACT;
constexpr size_t WS_BAR = WS_V + (size_t)MTOT * D * 2;
constexpr size_t WS_END = WS_BAR + (size_t)XCD_BAR_WORDS * 4;

struct Args { const float* in[30]; float* out; unsigned char* ws; };

typedef const float* cfp_t;
typedef const __attribute__((address_space(4))) unsigned char* kaptr_t;
__device__ __forceinline__ const unsigned char* ka_load(int byte_off) {
    kaptr_t ka = (kaptr_t)__builtin_amdgcn_kernarg_segment_ptr(); asm volatile("" : "+s"(ka));
    typedef __attribute__((address_space(1))) unsigned char* gptr_t;
    const gptr_t g = *(const gptr_t __attribute__((address_space(4)))*)(ka + byte_off);
    return (const unsigned char*)g;
}
struct InProxy { __device__ __forceinline__ const float* operator[](int i) const { return (const float*)ka_load(8 * i); } };
struct Ctx {
    InProxy in;
    float* out;
    unsigned char* ws;
    __device__ __forceinline__ half_t* v() const { return (half_t*)(ws + WS_V); }
    __device__ __forceinline__ bf16_t* wfi() const { return (bf16_t*)(ws + WS_WFI); }
    __device__ __forceinline__ bf16_t* wfo() const { return (bf16_t*)(ws + WS_WFO); }
    __device__ __forceinline__ bf16_t* wmi() const { return (bf16_t*)(ws + WS_WMI); }
    __device__ __forceinline__ bf16_t* wmo() const { return (bf16_t*)(ws + WS_WMO); }
    __device__ __forceinline__ bf16_t* wglu() const { return (bf16_t*)(ws + WS_WGLU); }
    __device__ __forceinline__ bf16_t* wsgu() const { return (bf16_t*)(ws + WS_WSGU); }
    __device__ __forceinline__ float* mod() const { return (float*)(ws + WS_MOD); }
    __device__ __forceinline__ bf16_t* dl() const { return (bf16_t*)(ws + WS_DL); }
    __device__ __forceinline__ bf16_t* dc() const { return (bf16_t*)(ws + WS_DC); }
    __device__ __forceinline__ f32x2v* s5a() const { return (f32x2v*)(ws + WS_S5A); }
    __device__ __forceinline__ bf16_t* s5b() const { return (bf16_t*)(ws + WS_S5B); }
    __device__ __forceinline__ bf16_t* s5c() const { return (bf16_t*)(ws + WS_S5C); }
    __device__ __forceinline__ float* pe() const { return (float*)(ws + WS_PE); }
    __device__ __forceinline__ f32x2v* stats() const { return (f32x2v*)(ws + WS_STATS); }
    __device__ __forceinline__ bf16_t* h() const { return (bf16_t*)(ws + WS_H); }
    __device__ __forceinline__ bf16_t* act() const { return (bf16_t*)(ws + WS_ACT); }
    __device__ __forceinline__ bf16_t* z() const { return (bf16_t*)(ws + WS_Z); }
    __device__ __forceinline__ bf16_t* ptl() const { return (bf16_t*)(ws + WS_PTL); }
    __device__ __forceinline__ bf16_t* ptc() const { return (bf16_t*)(ws + WS_PTC); }
    __device__ __forceinline__ bf16_t* ypart(int i) const { return (bf16_t*)(ws + WS_YF) + (size_t)i * MTOT * 256; }
    __device__ __forceinline__ bf16_t* yf() const { return (bf16_t*)(ws + WS_YF); }
    __device__ __forceinline__ bf16_t* yb() const { return (bf16_t*)(ws + WS_YB); }
    __device__ __forceinline__ bf16_t* ya() const { return (bf16_t*)(ws + WS_YA); }
    __device__ __forceinline__ bf16_t* vnt() const { return (bf16_t*)(ws + WS_VNT); }
    __device__ __forceinline__ bf16_t* ycat() const { return (bf16_t*)(ws + WS_YCAT); }
};
#define OPAQUE_CTX(X, Xin) Ctx X; X.out = (float*)ka_load(240); X.ws = (unsigned char*)ka_load(248); (void)Xin


__device__ __forceinline__ float bf2f(bf16_t x) { return __uint_as_float(((unsigned)x) << 16); }
__device__ __forceinline__ float bflo(unsigned w) { return __uint_as_float(w << 16); }
__device__ __forceinline__ float bfhi(unsigned w) { return __uint_as_float(w & 0xffff0000u); }
__device__ __forceinline__ bf16_t f2bf(float x) { return (bf16_t)(cvt_pk_bf16(x, 0.f) & 0xffffu); }
__device__ __forceinline__ float sigmoidf_(float x) { return __builtin_amdgcn_rcpf(1.0f + __builtin_amdgcn_exp2f(-1.4426950408889634f * x)); }
__device__ __forceinline__ float siluf_(float x) { return x * __builtin_amdgcn_rcpf(1.0f + __builtin_amdgcn_exp2f(-1.4426950408889634f * x)); }
__device__ __forceinline__ float geluf_(float x) { const float t = -2.3022081986f * (x + 0.044715f * x * x * x); return x * __builtin_amdgcn_rcpf(1.0f + __builtin_amdgcn_exp2f(t)); }
__device__ __forceinline__ int otid() { int t = threadIdx.x; asm volatile("" : "+v"(t)); return t; }
__device__ __forceinline__ float wave_sum(float x) {
#pragma unroll
    for (int o = 32; o > 0; o >>= 1) x += __shfl_xor(x, o);
    return x;
}

struct TcItem { const float* src; bf16_t* dst; int ldsrc, lddst, k0, n0s, n0d; };
__device__ __forceinline__ TcItem tc_decode(const Ctx& X, int it) {
    TcItem p;
    if (it < 11264) { const int li = it / 1408, rem = it % 1408, kt = rem / 88, nt = rem % 88;
        p.src = X.in[8] + (size_t)li * D * NFI; p.ldsrc = NFI; p.dst = X.wfi() + (size_t)li * NFI * D; p.lddst = D; p.k0 = kt * 64; p.n0s = nt * 64;
        if (p.n0s < DFF) p.n0d = (p.n0s >> 7) * 256 + (p.n0s & 127); else { const int j = p.n0s - DFF; p.n0d = (j >> 7) * 256 + 128 + (j & 127); } }
    else if (it < 16896) { const int i2 = it - 11264, li = i2 / 704, rem = i2 % 704, kt = rem / 16, nt = rem % 16;
        p.src = X.in[9] + (size_t)li * DFF * D; p.ldsrc = D; p.dst = X.wfo() + (size_t)li * D * DFF; p.lddst = DFF; p.k0 = kt * 64; p.n0s = nt * 64; p.n0d = p.n0s; }
    else if (it < 17152) { const int i2 = it - 16896, l = i2 / 64, rem = i2 % 64, kt = rem / 4, nt = rem % 4;
        p.src = X.in[10] + (size_t)l * D * 1280; p.ldsrc = 1280; p.dst = X.wmi() + (size_t)l * NMI * D; p.lddst = D; p.k0 = kt * 64; p.n0s = nt * 64; p.n0d = p.n0s; }
    else if (it < 17664) { const int i2 = it - 17152, l = i2 / 128, rem = i2 % 128, kt = rem / 8, nt = rem % 8;
        p.src = X.in[10] + (size_t)l * D * 1280; p.ldsrc = 1280; p.dst = X.wmi() + (size_t)l * NMI * D; p.lddst = D; p.k0 = kt * 64; p.n0s = 768 + nt * 64; p.n0d = 1024 + nt * 64; }
    else if (it < 18688) { const int i2 = it - 17664, l = i2 / 256, rem = i2 % 256, kt = rem / 16, nt = rem % 16;
        p.src = X.in[11] + (size_t)l * D * D; p.ldsrc = D; p.dst = X.wmo() + (size_t)l * D * D; p.lddst = D; p.k0 = kt * 64; p.n0s = nt * 64; p.n0d = p.n0s; }
    else { const int i2 = it - 18688, l = i2 / 16, rem = i2 % 16, kt = rem / 4, nt = rem % 4;
        p.src = X.in[21] + (size_t)l * 65536; p.ldsrc = 256; p.dst = X.wglu() + (size_t)l * 65536; p.lddst = 256; p.k0 = kt * 64; p.n0s = nt * 64; p.n0d = p.n0s; }
    return p;
}

__device__ __forceinline__ void phase0(const Ctx& Xin, LAS unsigned char* lds) {
    OPAQUE_CTX(X, Xin);
    const int tid = otid(), lane = tid & 63, wave = tid >> 6, G = gridDim.x, bid = blockIdx.x;
#ifndef P0MASK
#define P0MASK 0xFF
#endif
#define P0(k) if ((P0MASK >> (k)) & 1)
    P0(0) {
        LAS float* tile = (LAS float*)lds;
        const int r0 = tid >> 4, c0 = (tid & 15) * 4, nn = tid >> 3, k8 = (tid & 7) * 8;
        int it = bid;
        f32x4 va = {0.f, 0.f, 0.f, 0.f}, vb = va;
        TcItem p;
        if (it < 18752) { p = tc_decode(X, it);
            va = *(const f32x4*)(p.src + (size_t)(p.k0 + r0) * p.ldsrc + p.n0s + c0); vb = *(const f32x4*)(p.src + (size_t)(p.k0 + r0 + 32) * p.ldsrc + p.n0s + c0); }
        while (it < 18752) {
            tile[r0 * 65 + c0 + 0] = va[0]; tile[r0 * 65 + c0 + 1] = va[1]; tile[r0 * 65 + c0 + 2] = va[2]; tile[r0 * 65 + c0 + 3] = va[3];
            tile[(r0 + 32) * 65 + c0 + 0] = vb[0]; tile[(r0 + 32) * 65 + c0 + 1] = vb[1]; tile[(r0 + 32) * 65 + c0 + 2] = vb[2]; tile[(r0 + 32) * 65 + c0 + 3] = vb[3];
            __syncthreads();
            bf16_t* dstp = p.dst + (size_t)(p.n0d + nn) * p.lddst + p.k0 + k8;
            it += G;
            if (it < 18752) { p = tc_decode(X, it);
                va = *(const f32x4*)(p.src + (size_t)(p.k0 + r0) * p.ldsrc + p.n0s + c0); vb = *(const f32x4*)(p.src + (size_t)(p.k0 + r0 + 32) * p.ldsrc + p.n0s + c0); }
            float x[8];
#pragma unroll
            for (int j = 0; j < 8; ++j) x[j] = tile[(k8 + j) * 65 + nn];
            u32x4 w; w.x = cvt_pk_bf16(x[0], x[1]); w.y = cvt_pk_bf16(x[2], x[3]); w.z = cvt_pk_bf16(x[4], x[5]); w.w = cvt_pk_bf16(x[6], x[7]);
            *(u32x4*)dstp = w;
            __syncthreads();
        }
    }
    __syncthreads();
    P0(1) {
        LAS float* T = (LAS float*)lds;
        LAS float* ctab = (LAS float*)(lds + 32768);
        for (int u = bid; u < 256; u += G) {
            const int layer = u >> 6, kind = (u >> 3) & 7, kb = u & 7;
            if (tid < 64) ctab[tid] = cospif((float)tid * (1.0f / 32.0f));
            __syncthreads();
            if (kind < 4) {
                const float* fw = X.in[23] + (size_t)(layer * 4 + kind) * 4096;
                for (int e = tid; e < 8192; e += 512) {
                    const int c = e >> 7, j = e & 127, d = j & 63, sn = j >> 6;
                    float acc = 0.f;
                    for (int cp = 0; cp < 64; ++cp) { const int m = (c * cp - 16 * sn) & 63; acc += ctab[m] * fw[cp * 64 + d]; }
                    T[e] = acc;
                }
            } else {
                const float* pw = X.in[24] + (size_t)(layer * 4 + (kind - 4)) * 4096;
                for (int e = tid; e < 8192; e += 512) { const int c = e >> 7, j = e & 127; T[e] = (j < 64) ? pw[c * 64 + j] : 0.f; }
            }
            __syncthreads();
            {
                const int k = kb * 128 + (tid & 127), js = tid >> 7;
                const int coff = (kind < 4) ? 256 + kind * 64 : 512 + (kind - 4) * 64;
                const float* wr = X.in[10] + ((size_t)(layer * D + k)) * 1280 + coff;
                bf16_t* dstl = X.wmi() + (size_t)layer * NMI * D;
                f32x4 acc[8];
#pragma unroll
                for (int q = 0; q < 8; ++q) acc[q] = (f32x4){0.f, 0.f, 0.f, 0.f};
#pragma unroll 2
                for (int c = 0; c < 64; ++c) {
                    const float w = wr[c];
#pragma unroll
                    for (int q = 0; q < 8; ++q) acc[q] += w * *(LAS f32x4*)(T + c * 128 + js * 32 + q * 4);
                }
#pragma unroll
                for (int q = 0; q < 8; ++q)
#pragma unroll
                    for (int e = 0; e < 4; ++e) {
                        const int jc = js * 32 + q * 4 + e;
                        int n;
                        if (kind < 4) n = (jc < 64) ? (256 + kind * 64 + jc) : (512 + kind * 64 + (jc - 64));
                        else n = 768 + (kind - 4) * 64 + jc;
                        if (kind < 4 || jc < 64) dstl[(size_t)n * D + k] = f2bf(acc[q][e]);
                    }
            }
            __syncthreads();
        }
    }
    __syncthreads();
    P0(2) {
        LAS float* sv = (LAS float*)lds;
        LAS float* part = (LAS float*)(lds + 36864);
        for (int e = tid; e < 9 * 1024; e += 512) { const int cnd = e >> 10, k = e & 1023; const float c = (cnd < 8) ? X.in[2][cnd * 1024 + k] : X.in[5][k]; sv[e] = siluf_(c); }
        __syncthreads();
        for (int u = bid; u < 288; u += G) {
            const int layer = u / 72, chunk = u % 72, col = chunk * 128 + 2 * lane;
            float ax[9], ay[9];
#pragma unroll
            for (int c = 0; c < 9; ++c) { ax[c] = 0.f; ay[c] = 0.f; }
            const float* wp = X.in[6] + ((size_t)(layer * D + wave * 128)) * 9216 + col;
            for (int k = 0; k < 128; ++k) {
                const f32x2v wv = *(const f32x2v*)(wp + (size_t)k * 9216);
#pragma unroll
                for (int c = 0; c < 9; ++c) { const float s = sv[c * 1024 + wave * 128 + k]; ax[c] += s * wv.x; ay[c] += s * wv.y; }
            }
#pragma unroll
            for (int c = 0; c < 9; ++c) { part[(wave * 9 + c) * 128 + 2 * lane] = ax[c]; part[(wave * 9 + c) * 128 + 2 * lane + 1] = ay[c]; }
            __syncthreads();
            for (int e = tid; e < 1152; e += 512) {
                const int c = e >> 7, cc = e & 127; float s = 0.f;
#pragma unroll
                for (int w = 0; w < 8; ++w) s += part[(w * 9 + c) * 128 + cc];
                X.mod()[((size_t)(layer * 9 + c)) * 9216 + chunk * 128 + cc] = s + X.in[7][layer * 9216 + chunk * 128 + cc];
            }
            __syncthreads();
        }
    }
    __syncthreads();
    P0(3) {
        LAS float* tab = (LAS float*)lds;
        for (int m = tid; m < 4096; m += 512) tab[m] = cospif((float)m * (1.0f / 2048.0f));
        __syncthreads();
        for (int k = bid; k < 4096; k += G) {
#pragma unroll
            for (int i = 0; i < 2; ++i) {
                const int c8 = (tid + 512 * i) * 8;
                float x[8];
#pragma unroll
                for (int j = 0; j < 8; ++j) { const int col = c8 + j;
                    if (col < 4096) x[j] = tab[(k * col) & 4095] * (1.0f / 512.0f);
                    else x[j] = -tab[(k * (col - 4096) - 1024) & 4095] * (1.0f / 512.0f); }
                u32x4 w; w.x = cvt_pk_bf16(x[0], x[1]); w.y = cvt_pk_bf16(x[2], x[3]); w.z = cvt_pk_bf16(x[4], x[5]); w.w = cvt_pk_bf16(x[6], x[7]);
                *(u32x4*)(X.dl() + (size_t)k * 8192 + c8) = w;
            }
        }
        for (int k = bid; k < 256; k += G) {
            if (tid < 64) {
                const int c8 = tid * 8; float x[8];
#pragma unroll
                for (int j = 0; j < 8; ++j) { const int col = c8 + j;
                    if (col < 256) x[j] = tab[((k * col) & 255) * 16] * (1.0f / 128.0f);
                    else x[j] = -tab[((((k * (col - 256)) & 255) * 16) - 1024) & 4095] * (1.0f / 128.0f); }
                u32x4 w; w.x = cvt_pk_bf16(x[0], x[1]); w.y = cvt_pk_bf16(x[2], x[3]); w.z = cvt_pk_bf16(x[4], x[5]); w.w = cvt_pk_bf16(x[6], x[7]);
                *(u32x4*)(X.dc() + (size_t)k * 512 + c8) = w;
            }
        }
    }
    __syncthreads();
    P0(4) for (int u = bid; u < 128; u += G) {
        const float dt = expf(X.in[15][u]);
        for (int e = tid; e < 2048; e += 512) {
            const int col = e >> 4, ch = e & 15, blk = col >> 5, r = col & 31, p = r + 32 * (blk >> 1), ri = blk & 1;
            const float lr = X.in[13][u * 64 + p], li = X.in[14][u * 64 + p];
            const float ea = expf(lr * dt), ar = ea * cosf(li * dt), ai = ea * sinf(li * dt);
            const float den = lr * lr + li * li, nr = ar - 1.0f;
            const float cr = (nr * lr + ai * li) / den, ci = (ai * lr - nr * li) / den;
            const float br = X.in[16][((size_t)u * 64 + p) * 16 + ch], bi = X.in[17][((size_t)u * 64 + p) * 16 + ch];
            const float val = ri ? (cr * bi + ci * br) : (cr * br - ci * bi);
            X.s5b()[((size_t)u * 128 + col) * 16 + ch] = f2bf(val);
        }
        for (int e = tid; e < 2048; e += 512) {
            const int hp = e >> 7, kk = e & 127, r = kk >> 2, blk = kk & 3, p = r + 32 * (blk >> 1), ri = blk & 1;
            const float val = ri ? -X.in[19][((size_t)u * 16 + hp) * 64 + p] : X.in[18][((size_t)u * 16 + hp) * 64 + p];
            X.s5c()[((size_t)u * 16 + hp) * 128 + kk] = f2bf(val);
        }
        if (tid < 64) {
            const float lr = X.in[13][u * 64 + tid], li = X.in[14][u * 64 + tid];
            const float ea = expf(lr * dt);
            f32x2v a; a.x = ea * cosf(li * dt); a.y = ea * sinf(li * dt);
            X.s5a()[u * 64 + tid] = a;
        }
    }
    P0(5) {
        const size_t gt = (size_t)bid * 512 + tid, gs = (size_t)G * 512;
        for (size_t i = gt; i < (size_t)64 * 512; i += gs) {
            const int pos = (int)(i >> 9), cc = (int)(i & 511), ii = cc & 255;
            const float omega = 1.0f / powf(10000.0f, (float)ii * (1.0f / 256.0f));
            const float ang = (float)pos * omega;
            X.pe()[i] = (cc < 256) ? sinf(ang) : cosf(ang);
        }
        for (size_t i = gt; i < (size_t)4 * 4 * 128 * 128; i += gs) X.wsgu()[i] = f2bf(X.in[26][i]);
    }
}

__device__ __forceinline__ void lnmod_load(const Ctx& X, int row, int lane, bool first, f32x4 (&x)[4]) {
    if (!first) {
        const half_t* vr = X.v() + (size_t)row * D;
#pragma unroll
        for (int i = 0; i < 4; ++i) x[i] = __builtin_convertvector(*(const h4*)(vr + i * 256 + lane * 4), f32x4);
    } else if (row < MCTX) {
        const float* vr = X.in[0] + (size_t)row * D;
#pragma unroll
        for (int i = 0; i < 4; ++i) x[i] = *(const f32x4*)(vr + i * 256 + lane * 4);
    } else {
        const float* vr = X.in[1] + (size_t)(row - MCTX) * D;
        const int t = (row - MCTX) & 4095;
        const float* per = X.pe() + (size_t)(t >> 6) * 512, * pec = X.pe() + (size_t)(t & 63) * 512;
#pragma unroll
        for (int i = 0; i < 4; ++i) {
            const int col = i * 256 + lane * 4;
            x[i] = *(const f32x4*)(vr + col) + ((i < 2) ? *(const f32x4*)(per + col) : *(const f32x4*)(pec + col - 512));
        }
    }
}
__device__ __forceinline__ void lnmod_row(const Ctx& X, int row, int lane, bool first, bool do_ln, const f32x4 (&Gc)[4], const f32x4 (&Bc)[4], const float* modL, int sub, f32x4 (&x)[4], int& ccur, f32x4 (&SH)[4], f32x4 (&SC1)[4]) {
    float mean = 0.f, rstd = 1.f;
    if (do_ln) {
        float s = 0.f;
#pragma unroll
        for (int i = 0; i < 4; ++i) s += (x[i][0] + x[i][1]) + (x[i][2] + x[i][3]);
        mean = wave_sum(s) * (1.0f / 1024.0f);
        float q = 0.f;
#pragma unroll
        for (int i = 0; i < 4; ++i) { const f32x4 d = x[i] - mean; q += (d[0] * d[0] + d[1] * d[1]) + (d[2] * d[2] + d[3] * d[3]); }
        rstd = rsqrtf(wave_sum(q) * (1.0f / 1024.0f) + LN_EPS);
    }
    if (lane == 0) { f32x2v st; st.x = mean; st.y = rstd; X.stats()[row] = st; }
    const int cond = (row < MCTX) ? 8 : ((row - MCTX) >> 12);
    if (cond != ccur) {
        const float* sh = modL + (size_t)cond * 9216 + (sub * 3 + 0) * 1024;
        const float* sc = modL + (size_t)cond * 9216 + (sub * 3 + 1) * 1024;
#pragma unroll
        for (int i = 0; i < 4; ++i) { SH[i] = *(const f32x4*)(sh + i * 256 + lane * 4); SC1[i] = 1.0f + *(const f32x4*)(sc + i * 256 + lane * 4); }
        ccur = cond;
    }
#pragma unroll
    for (int i = 0; i < 4; ++i) {
        const int col = i * 256 + lane * 4;
        f32x4 xv = x[i];
        if (first) *(h4*)(X.v() + (size_t)row * D + col) = __builtin_convertvector(xv, h4);
        if (do_ln) xv = (xv - mean) * rstd * Gc[i] + Bc[i];
        const f32x4 hv = xv * SC1[i] + SH[i];
        u32x2 w; w.x = cvt_pk_bf16(hv[0], hv[1]); w.y = cvt_pk_bf16(hv[2], hv[3]);
        *(u32x2*)(X.h() + (size_t)row * D + col) = w;
    }
}
__device__ __forceinline__ void phase_lnmod(const Ctx& Xin, int layer, int sub, bool do_ln, const float* lnG, const float* lnB) {
    OPAQUE_CTX(X, Xin);
    const int tid_ = otid(), lane = tid_ & 63, gw = blockIdx.x * 8 + (tid_ >> 6), nw = gridDim.x * 8;
    const float* modL = X.mod() + (size_t)layer * 9 * 9216;
    const bool first = !do_ln;
    f32x4 Gc[4], Bc[4];
#pragma unroll
    for (int i = 0; i < 4; ++i) { Gc[i] = *(const f32x4*)(lnG + i * 256 + lane * 4); Bc[i] = *(const f32x4*)(lnB + i * 256 + lane * 4); }
    const int rpw = (MTOT + nw - 1) / nw, rbeg = gw * rpw, rend = (rbeg + rpw) < MTOT ? (rbeg + rpw) : MTOT;
    int ccur = -1; f32x4 SH[4], SC1[4];
    for (int row = rbeg; row < rend; row += 3) {
        const int rowb = row + 1, rowc = row + 2;
        f32x4 xa[4], xb[4], xc[4];
        lnmod_load(X, row, lane, first, xa);
        if (rowb < rend) lnmod_load(X, rowb, lane, first, xb);
        if (rowc < rend) lnmod_load(X, rowc, lane, first, xc);
        lnmod_row(X, row, lane, first, do_ln, Gc, Bc, modL, sub, xa, ccur, SH, SC1);
        if (rowb < rend) lnmod_row(X, rowb, lane, first, do_ln, Gc, Bc, modL, sub, xb, ccur, SH, SC1);
        if (rowc < rend) lnmod_row(X, rowc, lane, first, do_ln, Gc, Bc, modL, sub, xc, ccur, SH, SC1);
    }
}

__device__ __forceinline__ void final_ln_load(const Ctx& X, int row, int lane, f32x4 (&x)[4]) {
    const half_t* vr = X.v() + (size_t)row * D;
#pragma unroll
    for (int i = 0; i < 4; ++i) x[i] = __builtin_convertvector(*(const h4*)(vr + i * 256 + lane * 4), f32x4);
}
__device__ __forceinline__ void final_ln_row(const Ctx& X, int row, int lane, const f32x4 (&x)[4], const f32x4 (&Gc)[4], const f32x4 (&Bc)[4]) {
    float* orow = X.out + (size_t)row * D;
    float s = 0.f;
#pragma unroll
    for (int i = 0; i < 4; ++i) s += (x[i][0] + x[i][1]) + (x[i][2] + x[i][3]);
    const float mean = wave_sum(s) * (1.0f / 1024.0f);
    float q = 0.f;
#pragma unroll
    for (int i = 0; i < 4; ++i) { const f32x4 d = x[i] - mean; q += (d[0] * d[0] + d[1] * d[1]) + (d[2] * d[2] + d[3] * d[3]); }
    const float rstd = rsqrtf(wave_sum(q) * (1.0f / 1024.0f) + LN_EPS);
#pragma unroll
    for (int i = 0; i < 4; ++i) *(f32x4*)(orow + i * 256 + lane * 4) = (x[i] - mean) * rstd * Gc[i] + Bc[i];
}
__device__ __forceinline__ void phase_final_ln(const Ctx& Xin, const float* lnG, const float* lnB) {
    OPAQUE_CTX(X, Xin);
    const int tid_ = otid(), lane = tid_ & 63, gw = blockIdx.x * 8 + (tid_ >> 6), nw = gridDim.x * 8;
    f32x4 Gc[4], Bc[4];
#pragma unroll
    for (int i = 0; i < 4; ++i) { Gc[i] = *(const f32x4*)(lnG + i * 256 + lane * 4); Bc[i] = *(const f32x4*)(lnB + i * 256 + lane * 4); }
    const int rpw = (MTOT + nw - 1) / nw, rbeg = gw * rpw, rend = (rbeg + rpw) < MTOT ? (rbeg + rpw) : MTOT;
    for (int row = rbeg; row < rend; row += 3) {
        const int rowb = row + 1, rowc = row + 2;
        f32x4 xa[4], xb[4], xc[4];
        final_ln_load(X, row, lane, xa);
        if (rowb < rend) final_ln_load(X, rowb, lane, xb);
        if (rowc < rend) final_ln_load(X, rowc, lane, xc);
        final_ln_row(X, row, lane, xa, Gc, Bc);
        if (rowb < rend) final_ln_row(X, rowb, lane, xb, Gc, Bc);
        if (rowc < rend) final_ln_row(X, rowc, lane, xc, Gc, Bc);
    }
}

struct EpiSwiGLU {
    static constexpr bool PERM = true, AFTER_DRAIN = false;
    bf16_t* act;
    __device__ __forceinline__ void operator()(const f32x4 (&acc)[2][2][4][2], const Unit& u, int wr, int wc, int fr, int fq) const {
        const int row0 = u.pm * 256 + wr * 64 + fr, colo = u.pn * 128 + wc * 32 + 8 * fq;
#pragma unroll
        for (int ai = 0; ai < 2; ++ai)
#pragma unroll
            for (int m = 0; m < 4; ++m) {
                const int row = row0 + ai * 128 + m * 16;
                float o[8];
#pragma unroll
                for (int n = 0; n < 2; ++n)
#pragma unroll
                    for (int j = 0; j < 4; ++j) o[n * 4 + j] = siluf_(acc[ai][1][m][n][j]) * acc[ai][0][m][n][j];
                u32x4 w; w.x = cvt_pk_bf16(o[0], o[1]); w.y = cvt_pk_bf16(o[2], o[3]); w.z = cvt_pk_bf16(o[4], o[5]); w.w = cvt_pk_bf16(o[6], o[7]);
                *(u32x4*)(act + (size_t)row * DFF + colo) = w;
            }
    }
};

#ifdef PROBE_FFNOUT
constexpr long VOUT_DELTA_PROBE = ((long)(WS_ACT + (size_t)MTOT * DFF * 2) - (long)WS_V) / 2;
#else
constexpr long VOUT_DELTA_PROBE = 0;
#endif
template <int OOP> struct EpiResT {
    static constexpr bool PERM = true, AFTER_DRAIN = false;
    half_t* v; const f32x2v* stats; const float* lnG; const float* lnB; const float* modL; int gate_k; float coef; int do_ln;
    __device__ __forceinline__ void operator()(const f32x4 (&acc)[2][2][4][2], const Unit& u, int wr, int wc, int fr, int fq) const {
        const int cond = (u.pm < 16) ? 8 : ((u.pm - 16) >> 4);
        const float* gate = modL + (size_t)cond * 9216 + gate_k * 1024;
        const int row0 = u.pm * 256 + wr * 64 + fr, col0 = u.pn * 256 + wc * 32 + 8 * fq;
#pragma unroll
        for (int bj = 0; bj < 2; ++bj) {
            const int col = col0 + bj * 128;
            const f32x4 g0 = *(const f32x4*)(gate + col) * coef, g1 = *(const f32x4*)(gate + col + 4) * coef;
            f32x4 G0 = {1.f, 1.f, 1.f, 1.f}, G1 = G0, B0 = {0.f, 0.f, 0.f, 0.f}, B1 = B0;
            if (do_ln) { G0 = *(const f32x4*)(lnG + col); G1 = *(const f32x4*)(lnG + col + 4); B0 = *(const f32x4*)(lnB + col); B1 = *(const f32x4*)(lnB + col + 4); }
#pragma unroll
            for (int ai = 0; ai < 2; ++ai) {
                h8 hv[4]; f32x2v st[4];
#pragma unroll
                for (int m = 0; m < 4; ++m) {
                    const int row = row0 + ai * 128 + m * 16;
                    hv[m] = *(const h8*)(v + (size_t)row * D + col);
                    f32x2v t; t.x = 0.f; t.y = 1.f; if (do_ln) t = stats[row]; st[m] = t;
                }
                asm volatile("" ::: "memory");
#pragma unroll
                for (int m = 0; m < 4; ++m) {
                    const h8 h = hv[m];
                    f32x4 x0 = {(float)h[0], (float)h[1], (float)h[2], (float)h[3]}, x1 = {(float)h[4], (float)h[5], (float)h[6], (float)h[7]};
                    const f32x2v s2 = st[m];
                    x0 = (x0 - s2.x) * s2.y * G0 + B0; x1 = (x1 - s2.x) * s2.y * G1 + B1;
                    x0 = ALPHA * x0 + g0 * acc[ai][bj][m][0]; x1 = ALPHA * x1 + g1 * acc[ai][bj][m][1];
                    h8 o; o[0] = (half_t)x0[0]; o[1] = (half_t)x0[1]; o[2] = (half_t)x0[2]; o[3] = (half_t)x0[3]; o[4] = (half_t)x1[0]; o[5] = (half_t)x1[1]; o[6] = (half_t)x1[2]; o[7] = (half_t)x1[3];
                    *(h8*)(v + (size_t)(row0 + ai * 128 + m * 16) * D + col + (OOP ? VOUT_DELTA_PROBE : 0)) = o;
                }
                asm volatile("" ::: "memory");
            }
        }
    }
};

struct EpiMixIn {
    static constexpr bool PERM = true, AFTER_DRAIN = false;
    bf16_t *z, *ptl, *ptc;
    __device__ __forceinline__ void operator()(const f32x4 (&acc)[2][2][4][2], const Unit& u, int wr, int wc, int fr, int fq) const {
        const int row0 = u.pm * 256 + wr * 64 + fr;
        if (u.pn == 1 || u.pn == 2) {
            const int cs = u.pn - 1;
#pragma unroll
            for (int ai = 0; ai < 2; ++ai)
#pragma unroll
                for (int m = 0; m < 4; ++m) {
                    const int row = row0 + ai * 128 + m * 16;
                    bf16_t* base; size_t stride;
                    if (row < MCTX) { const int b = row >> 8, n = row & 255; base = ptc + ((size_t)(b * 256)) * 512 + cs * 256 + n; stride = 512; }
                    else { const int r2 = row - MCTX, b = r2 >> 12, n = r2 & 4095; base = ptl + ((size_t)(b * 256)) * 8192 + cs * 4096 + n; stride = 8192; }
#pragma unroll
                    for (int bj = 0; bj < 2; ++bj)
#pragma unroll
                        for (int n = 0; n < 2; ++n)
#pragma unroll
                            for (int j = 0; j < 4; ++j) { const int hd = bj * 128 + wc * 32 + 8 * fq + 4 * n + j; base[(size_t)hd * stride] = f2bf(acc[ai][bj][m][n][j]); }
                    asm volatile("" ::: "memory");
                }
        } else {
            const int zc0 = (u.pn == 0) ? 0 : (u.pn == 3 ? 256 : (u.pn == 4 ? 512 : 768));
#pragma unroll
            for (int ai = 0; ai < 2; ++ai)
#pragma unroll
                for (int m = 0; m < 4; ++m) {
                    const int row = row0 + ai * 128 + m * 16;
#pragma unroll
                    for (int bj = 0; bj < 2; ++bj) {
                        const f32x4 a0 = acc[ai][bj][m][0], a1 = acc[ai][bj][m][1];
                        u32x4 w; w.x = cvt_pk_bf16(a0[0], a0[1]); w.y = cvt_pk_bf16(a0[2], a0[3]); w.z = cvt_pk_bf16(a1[0], a1[1]); w.w = cvt_pk_bf16(a1[2], a1[3]);
                        *(u32x4*)(z + (size_t)row * D + zc0 + bj * 128 + wc * 32 + 8 * fq) = w;
                    }
                    asm volatile("" ::: "memory");
                }
        }
    }
};

struct EpiDft {
    static constexpr bool PERM = true, AFTER_DRAIN = false;
    bf16_t* ycat; int rowbase, seqlen;
    __device__ __forceinline__ void operator()(const f32x4 (&acc)[2][2][4][2], const Unit& u, int wr, int wc, int fr, int fq) const {
        const int row0 = rowbase + u.pn * seqlen + u.pm * 256 + wr * 64 + fr;
#pragma unroll
        for (int ai = 0; ai < 2; ++ai)
#pragma unroll
            for (int m = 0; m < 4; ++m) {
                const int row = row0 + ai * 128 + m * 16;
#pragma unroll
                for (int bj = 0; bj < 2; ++bj) {
                    const f32x4 a0 = acc[ai][bj][m][0], a1 = acc[ai][bj][m][1];
                    u32x4 w; w.x = cvt_pk_bf16(a0[0], a0[1]); w.y = cvt_pk_bf16(a0[2], a0[3]); w.z = cvt_pk_bf16(a1[0], a1[1]); w.w = cvt_pk_bf16(a1[2], a1[3]);
                    *(u32x4*)(ycat + (size_t)row * D + 256 + bj * 128 + wc * 32 + 8 * fq) = w;
                }
            }
    }
};

struct EpiGlu {
    static constexpr bool PERM = true, AFTER_DRAIN = false;
    const bf16_t* ya; bf16_t* ycat; const float* bias;
    __device__ __forceinline__ void operator()(const f32x4 (&acc)[2][2][4][2], const Unit& u, int wr, int wc, int fr, int fq) const {
        const int row0 = u.pm * 256 + wr * 64 + fr;
#pragma unroll
        for (int bj = 0; bj < 2; ++bj) {
            const int lc = bj * 128 + wc * 32 + 8 * fq;
            const f32x4 b0 = *(const f32x4*)(bias + lc), b1 = *(const f32x4*)(bias + lc + 4);
#pragma unroll
            for (int ai = 0; ai < 2; ++ai) {
                u32x4 yv[4];
#pragma unroll
                for (int m = 0; m < 4; ++m) yv[m] = *(const u32x4*)(ya + (size_t)(row0 + ai * 128 + m * 16) * 256 + lc);
                asm volatile("" ::: "memory");
#pragma unroll
                for (int m = 0; m < 4; ++m) {
                    const int row = row0 + ai * 128 + m * 16;
                    const u32x4 y4 = yv[m];
                    const f32x4 a0 = acc[ai][bj][m][0] + b0, a1 = acc[ai][bj][m][1] + b1;
                    float o[8];
                    o[0] = bflo(y4.x) * sigmoidf_(a0[0]); o[1] = bfhi(y4.x) * sigmoidf_(a0[1]); o[2] = bflo(y4.y) * sigmoidf_(a0[2]); o[3] = bfhi(y4.y) * sigmoidf_(a0[3]);
                    o[4] = bflo(y4.z) * sigmoidf_(a1[0]); o[5] = bfhi(y4.z) * sigmoidf_(a1[1]); o[6] = bflo(y4.w) * sigmoidf_(a1[2]); o[7] = bfhi(y4.w) * sigmoidf_(a1[3]);
                    u32x4 w; w.x = cvt_pk_bf16(o[0], o[1]); w.y = cvt_pk_bf16(o[2], o[3]); w.z = cvt_pk_bf16(o[4], o[5]); w.w = cvt_pk_bf16(o[6], o[7]);
                    *(u32x4*)(ycat + (size_t)row * D + lc) = w;
                }
                asm volatile("" ::: "memory");
            }
        }
    }
};

__device__ __forceinline__ void s5_unit(const Ctx& Xin, LAS unsigned char* hl, int layer, int dir, int g, int ph, int rowA, int rowB, int L, int bA, int bB, bool latent) {
    OPAQUE_CTX(X, Xin);
    const int lane = otid() & 63, r = lane & 31, half = lane >> 5;
    const int ldg = (layer * 2 + dir) * 16 + g;
    bf16x8 bfr[2], cfr[4];
#pragma unroll
    for (int i = 0; i < 2; ++i) bfr[i] = *(const bf16x8*)(X.s5b() + ((size_t)(ldg * 128 + (2 * ph + i) * 32 + r)) * 16 + 8 * half);
#pragma unroll
    for (int s = 0; s < 4; ++s) {
        u32x4 c = {0u, 0u, 0u, 0u};
        if (r < 16) {
            const bf16_t* cp = X.s5c() + ((size_t)(ldg * 16 + r)) * 128 + 4 * (8 * s + 4 * half) + 2 * ph;
            c.x = *(const unsigned*)(cp); c.y = *(const unsigned*)(cp + 4); c.z = *(const unsigned*)(cp + 8); c.w = *(const unsigned*)(cp + 12);
        }
        cfr[s] = __builtin_bit_cast(bf16x8, c);
    }
    const f32x2v a0 = X.s5a()[ldg * 64 + r + 32 * ph];
    float s0r = 0.f, s0i = 0.f;
    const int myb = half ? bB : bA;
    const size_t sidx = ((size_t)((myb * 4 + layer) * 2 + dir) * 16 + g) * 64 + r + 32 * ph;
    if (latent) { s0r = X.in[3][sidx]; s0i = X.in[4][sidx]; }
    const int hs = (r >> 2) & 1, jA = (r & 3) + 4 * (r >> 3);
    const bf16_t* ubase = X.z() + (size_t)((hs ? rowB : rowA) + (dir ? 15 - jA : jA)) * D + g * 16 + 8 * half;
    LAS unsigned char* ys = hl + 4608;
    const int srho = lane >> 1, spart = lane & 1, sseq = (srho >> 2) & 1, sj = (srho & 3) + 4 * (srho >> 3);
    bf16_t* ybase = X.ypart(dir * 2 + ph) + (size_t)((sseq ? rowB : rowA) + (dir ? 15 - sj : sj)) * 256 + g * 16 + spart * 8;
    const int ngrp = L >> 4;
    bf16x8 afr = *(const bf16x8*)(ubase + (size_t)(dir ? (L - 16) : 0) * D);
    asm volatile("" : "+v"(afr));
    for (int it = 0; it < ngrp; ++it) {
        const int t0 = dir ? (L - 16 * (it + 1)) : (16 * it);
        const int tn = (it + 1 < ngrp) ? (dir ? (t0 - 16) : (t0 + 16)) : t0;
        const bf16x8 anext = *(const bf16x8*)(ubase + (size_t)tn * D);
        const f32x16 zero16 = {0.f, 0.f, 0.f, 0.f, 0.f, 0.f, 0.f, 0.f, 0.f, 0.f, 0.f, 0.f, 0.f, 0.f, 0.f, 0.f};
        const f32x16 bu0 = __builtin_amdgcn_mfma_f32_32x32x16_bf16(afr, bfr[0], zero16, 0, 0, 0);
        const f32x16 bu1 = __builtin_amdgcn_mfma_f32_32x32x16_bf16(afr, bfr[1], zero16, 0, 0, 0);
#pragma unroll
        for (int j = 0; j < 16; ++j) {
            const float n0r = __builtin_fmaf(a0.x, s0r, __builtin_fmaf(-a0.y, s0i, bu0[j])), n0i = __builtin_fmaf(a0.x, s0i, __builtin_fmaf(a0.y, s0r, bu1[j]));
            s0r = n0r; s0i = n0i;
            const int rho = (j & 3) + 8 * (j >> 2);
            *(LAS unsigned*)(hl + (rho + 4 * half) * 144 + r * 4) = cvt_pk_bf16(s0r, s0i);
        }
        asm volatile("s_waitcnt lgkmcnt(0)" ::: "memory");
        f32x16 y0 = zero16, y1 = zero16;
#pragma unroll
        for (int s = 0; s < 4; s += 2) {
            const bf16x8 ha = *(const LAS bf16x8*)(hl + r * 144 + (16 * s + 8 * half) * 2);
            const bf16x8 hb = *(const LAS bf16x8*)(hl + r * 144 + (16 * (s + 1) + 8 * half) * 2);
            y0 = __builtin_amdgcn_mfma_f32_32x32x16_bf16(ha, cfr[s], y0, 0, 0, 0);
            y1 = __builtin_amdgcn_mfma_f32_32x32x16_bf16(hb, cfr[s + 1], y1, 0, 0, 0);
        }
        if (r < 16) {
#pragma unroll
            for (int j = 0; j < 16; ++j) { const int rho = (j & 3) + 8 * (j >> 2);
                *(LAS bf16_t*)(ys + (rho + 4 * half) * 32 + r * 2) = f2bf(y0[j] + y1[j]); }
        }
        asm volatile("s_waitcnt lgkmcnt(0)" ::: "memory");
        const u32x4 yv = *(const LAS u32x4*)(ys + srho * 32 + spart * 16);
        *(u32x4*)(ybase + (size_t)t0 * 256) = yv;
        asm volatile("s_waitcnt lgkmcnt(0)" ::: "memory");
        afr = anext;
    }
    if (!latent) { X.out[OUT_RE + sidx] = s0r; X.out[OUT_IM + sidx] = s0i; }
}

__device__ __forceinline__ void sgu_prep_item(const Ctx& Xin, int witem) {
    OPAQUE_CTX(X, Xin);
    const int lane = otid() & 63, g = witem & 3, row = (witem >> 2) * 64 + lane;
    const bf16_t* zp = X.z() + (size_t)row * D + 768 + g * 64;
    float x[64];
#pragma unroll
    for (int q = 0; q < 8; ++q) {
        const u32x4 w = *(const u32x4*)(zp + q * 8);
        x[q * 8 + 0] = geluf_(bflo(w.x)); x[q * 8 + 1] = geluf_(bfhi(w.x)); x[q * 8 + 2] = geluf_(bflo(w.y)); x[q * 8 + 3] = geluf_(bfhi(w.y));
        x[q * 8 + 4] = geluf_(bflo(w.z)); x[q * 8 + 5] = geluf_(bfhi(w.z)); x[q * 8 + 6] = geluf_(bflo(w.w)); x[q * 8 + 7] = geluf_(bfhi(w.w));
    }
    float s = 0.f;
#pragma unroll
    for (int c = 0; c < 64; ++c) s += x[c];
    const float mean = s * (1.0f / 64.0f);
    float q2 = 0.f;
#pragma unroll
    for (int c = 0; c < 64; ++c) { const float d = x[c] - mean; q2 += d * d; }
    const float rstd = rsqrtf(q2 * (1.0f / 64.0f) + LN_EPS);
    bf16_t* dst = X.vnt() + ((size_t)((row >> 7) * 4 + g)) * 64 * 128 + (row & 127);
#pragma unroll
    for (int c = 0; c < 64; ++c) dst[c * 128] = f2bf((x[c] - mean) * rstd);
}

__device__ __forceinline__ void sgu_chunk_wave(const Ctx& Xin, int layer, int chunk) {
#pragma nounroll
    for (int q = 0; q < 8; ++q) sgu_prep_item(Xin, (((chunk * 2 + (q >> 2)) << 2) | (q & 3)));
    asm volatile("s_waitcnt vmcnt(0)" ::: "memory");
    OPAQUE_CTX(X, Xin);
    const int lane = otid() & 63, r = lane & 31, half = lane >> 5;
#pragma nounroll
    for (int gt = 0; gt < 16; ++gt) {
        const int g = gt >> 2, tr = gt & 3;
        const bf16_t* Ap = X.wsgu() + ((size_t)((layer * 4 + g) * 128 + tr * 32 + r)) * 128 + 8 * half;
        const float* sb = X.in[27] + (layer * 4 + g) * 128;
        bf16x8 af[8];
#pragma unroll
        for (int s = 0; s < 8; ++s) af[s] = *(const bf16x8*)(Ap + 16 * s);
#pragma unroll
        for (int tc = 0; tc < 2; ++tc) {
            const bf16_t* Bp = X.vnt() + ((size_t)((chunk * 4 + g) * 64 + tc * 32 + r)) * 128 + 8 * half;
            const int c = tc * 32 + r;
            bf16_t uu[16]; float bs[16];
#pragma unroll
            for (int j = 0; j < 16; ++j) {
                const int t = tr * 32 + (j & 3) + 8 * (j >> 2) + 4 * half, row = chunk * 128 + t;
                uu[j] = X.z()[(size_t)row * D + 512 + g * 64 + c]; bs[j] = sb[t];
            }
            f32x16 acc = {0.f, 0.f, 0.f, 0.f, 0.f, 0.f, 0.f, 0.f, 0.f, 0.f, 0.f, 0.f, 0.f, 0.f, 0.f, 0.f};
#pragma unroll
            for (int s = 0; s < 8; ++s) {
                const bf16x8 b = *(const bf16x8*)(Bp + 16 * s);
                acc = __builtin_amdgcn_mfma_f32_32x32x16_bf16(af[s], b, acc, 0, 0, 0);
            }
            asm volatile("" ::: "memory");
#pragma unroll
            for (int j = 0; j < 16; ++j) {
                const int t = tr * 32 + (j & 3) + 8 * (j >> 2) + 4 * half, row = chunk * 128 + t;
                X.ycat()[(size_t)row * D + 768 + g * 64 + c] = f2bf(geluf_(bf2f(uu[j])) * (acc[j] + bs[j]));
            }
            asm volatile("" ::: "memory");
        }
    }
}

__device__ __forceinline__ void phase_l7(const Ctx& Xin, int layer) {
    OPAQUE_CTX(X, Xin);
    const int tid = otid(), lane = tid & 63, wave = tid >> 6, G = gridDim.x;
    {
        const float* dsk = X.in[20] + layer * 256;
        const size_t gt = (size_t)blockIdx.x * 512 + tid, gs = (size_t)G * 512;
        const int c8h = (int)(gt & 31) * 8;
        const f32x4 d0 = *(const f32x4*)(dsk + c8h), d1 = *(const f32x4*)(dsk + c8h + 4);
        for (size_t i0 = gt; i0 < (size_t)MTOT * 32; i0 += 3 * gs) {
            u32x4 uw[3], f0[3], f1[3], b0[3], b1[3];
#pragma unroll
            for (int q = 0; q < 3; ++q) {
                const size_t i = i0 + (size_t)q * gs;
                if (i < (size_t)MTOT * 32) {
                    const int row = (int)(i >> 5), c8 = (int)(i & 31) * 8;
                    uw[q] = *(const u32x4*)(X.z() + (size_t)row * D + c8);
                    f0[q] = *(const u32x4*)(X.ypart(0) + (size_t)row * 256 + c8); f1[q] = *(const u32x4*)(X.ypart(1) + (size_t)row * 256 + c8);
                    b0[q] = *(const u32x4*)(X.ypart(2) + (size_t)row * 256 + c8); b1[q] = *(const u32x4*)(X.ypart(3) + (size_t)row * 256 + c8);
                }
            }
            asm volatile("" ::: "memory");
#pragma unroll
            for (int q = 0; q < 3; ++q) {
                const size_t i = i0 + (size_t)q * gs;
                if (i < (size_t)MTOT * 32) {
                    const int row = (int)(i >> 5), c8 = (int)(i & 31) * 8;
                    const u32x4 U = uw[q], F0 = f0[q], F1 = f1[q], B0 = b0[q], B1 = b1[q];
                    const f32x4 plo = {bflo(F0.x) + bflo(F1.x) + bflo(B0.x) + bflo(B1.x), bfhi(F0.x) + bfhi(F1.x) + bfhi(B0.x) + bfhi(B1.x), bflo(F0.y) + bflo(F1.y) + bflo(B0.y) + bflo(B1.y), bfhi(F0.y) + bfhi(F1.y) + bfhi(B0.y) + bfhi(B1.y)};
                    const f32x4 phi = {bflo(F0.z) + bflo(F1.z) + bflo(B0.z) + bflo(B1.z), bfhi(F0.z) + bfhi(F1.z) + bfhi(B0.z) + bfhi(B1.z), bflo(F0.w) + bflo(F1.w) + bflo(B0.w) + bflo(B1.w), bfhi(F0.w) + bfhi(F1.w) + bfhi(B0.w) + bfhi(B1.w)};
                    float o[8];
                    o[0] = geluf_(bflo(U.x) * d0[0] + plo[0]); o[1] = geluf_(bfhi(U.x) * d0[1] + plo[1]);
                    o[2] = geluf_(bflo(U.y) * d0[2] + plo[2]); o[3] = geluf_(bfhi(U.y) * d0[3] + plo[3]);
                    o[4] = geluf_(bflo(U.z) * d1[0] + phi[0]); o[5] = geluf_(bfhi(U.z) * d1[1] + phi[1]);
                    o[6] = geluf_(bflo(U.w) * d1[2] + phi[2]); o[7] = geluf_(bfhi(U.w) * d1[3] + phi[3]);
                    u32x4 w; w.x = cvt_pk_bf16(o[0], o[1]); w.y = cvt_pk_bf16(o[2], o[3]); w.z = cvt_pk_bf16(o[4], o[5]); w.w = cvt_pk_bf16(o[6], o[7]);
                    *(u32x4*)(X.ya() + (size_t)row * 256 + c8) = w;
                }
            }
            asm volatile("" ::: "memory");
        }
    }
}

struct FinRaw { u32x2 ya, yb, yd, qt, wq[16]; };
__device__ __forceinline__ void fin_load(const Ctx& X, int row, int lane, FinRaw& R) {
    const int c4 = 4 * lane;
    int sb, n, t;
    if (row < MCTX) { sb = row & ~255; n = 256; t = row & 255; } else { const int r2 = row - MCTX; sb = MCTX + (r2 & ~4095); n = 4096; t = r2 & 4095; }
    R.ya = *(const u32x2*)(X.ycat() + (size_t)row * D + c4);
    R.yb = *(const u32x2*)(X.ycat() + (size_t)row * D + 256 + c4);
    R.yd = *(const u32x2*)(X.ycat() + (size_t)row * D + 768 + c4);
    R.qt = *(const u32x2*)(X.z() + (size_t)row * D + 256 + c4);
    const int hw = 1 << (lane >> 4);
    const bf16_t* qb = X.z() + (size_t)sb * D + 256 + c4;
#pragma unroll
    for (int i = 0; i < 16; ++i) { int sidx = t - hw + i; sidx = sidx < 0 ? 0 : (sidx > n - 1 ? n - 1 : sidx); R.wq[i] = *(const u32x2*)(qb + (size_t)sidx * D); }
}
__device__ __forceinline__ f32x4 up4(u32x2 w) { return (f32x4){bflo(w.x), bfhi(w.x), bflo(w.y), bfhi(w.y)}; }
__device__ __forceinline__ void fin_row(const Ctx& X, int row, int lane, const FinRaw& R, const f32x4 (&png4)[4], f32x4 ps) {
    const int c4 = 4 * lane;
    int n, t;
    if (row < MCTX) { n = 256; t = row & 255; } else { n = 4096; t = (row - MCTX) & 4095; }
    const int hw = 1 << (lane >> 4);
    const int lo = (t - hw) < 0 ? 0 : (t - hw), hi = (t + hw) > n ? n : (t + hw);
    f32x4 y[4];
    y[0] = up4(R.ya); y[1] = up4(R.yb); y[3] = up4(R.yd);
    f32x4 sum = {0.f, 0.f, 0.f, 0.f};
#pragma unroll
    for (int i = 0; i < 16; ++i) { const int sidx = t - hw + i; const float m = (i < 2 * hw && sidx >= 0 && sidx < n) ? 1.0f : 0.0f; sum += m * up4(R.wq[i]); }
    y[2] = (sum * (1.0f / (float)(hi - lo)) - up4(R.qt)) * ps;
#pragma unroll
    for (int gq = 0; gq < 4; ++gq) {
        const f32x4 v = y[gq];
        const float ss = wave_sum((v[0] * v[0] + v[1] * v[1]) + (v[2] * v[2] + v[3] * v[3]));
        const float sc = rsqrtf(ss * (1.0f / 256.0f) + LN_EPS);
        const f32x4 o = v * sc * png4[gq];
        u32x2 w; w.x = cvt_pk_bf16(o[0], o[1]); w.y = cvt_pk_bf16(o[2], o[3]);
        *(u32x2*)(X.h() + (size_t)row * D + gq * 256 + c4) = w;
    }
}
__device__ __forceinline__ void phase_finalize(const Ctx& Xin, int layer) {
    OPAQUE_CTX(X, Xin);
    const int tid_ = otid(), lane = tid_ & 63, gw = blockIdx.x * 8 + (tid_ >> 6), nw = gridDim.x * 8;
    const float* png = X.in[12] + layer * 1024;
    const f32x4 ps = *(const f32x4*)(X.in[25] + layer * 256 + 4 * lane);
    f32x4 png4[4];
#pragma unroll
    for (int gq = 0; gq < 4; ++gq) png4[gq] = *(const f32x4*)(png + gq * 256 + 4 * lane);
    for (int row = gw; row < MTOT; row += 2 * nw) {
        const int rowb = row + nw;
        FinRaw Ra, Rb;
        fin_load(X, row, lane, Ra);
        if (rowb < MTOT) fin_load(X, rowb, lane, Rb);
        fin_row(X, row, lane, Ra, png4, ps);
        if (rowb < MTOT) fin_row(X, rowb, lane, Rb, png4, ps);
    }
}

__global__ void __launch_bounds__(512, 2) fwd_megakernel(Args a) {
    extern __shared__ __attribute__((aligned(16))) unsigned char lds_raw[];
    LAS unsigned char* lds = (LAS unsigned char*)lds_raw;
    cg::grid_group grid = cg::this_grid();
    Ctx X0; X0.out = a.out; X0.ws = a.ws;
    const int G = gridDim.x, bid = blockIdx.x;

#ifndef PHMASK
#define PHMASK 0xFFFF
#endif
#ifndef DUPMASK
#define DUPMASK 0
#endif
#define PH(k) _Pragma("nounroll") for (int rep_ = 0; rep_ < (((DUPMASK) >> (k)) & 1) + 1; ++rep_)
    if (threadIdx.x < 4) ((LAS unsigned*)(lds + 131072))[threadIdx.x] = 0u;
    if (bid == 0) { unsigned* bw = (unsigned*)(a.ws + WS_BAR); for (int i = threadIdx.x; i < XCD_BAR_WORDS; i += 512) bw[i] = 0u; }
    __syncthreads();
    PH(0) phase0(X0, lds);
    grid.sync();
    const XcdBarrier xbar = xcd_barrier_post((unsigned*)(a.ws + WS_BAR), (volatile LAS unsigned*)(lds + 131072));
#define GSYNC() xcd_barrier(xbar)

    for (int sl = 0; sl < 12; ++sl) {
        const int layer = sl / 3, sub = sl % 3;
        const int do_ln = sl > 0;
        OPAQUE_CTX(X, X0);
        const float* pG = X.in[28] + (size_t)(do_ln ? sl - 1 : 0) * D;
        const float* pB = X.in[29] + (size_t)(do_ln ? sl - 1 : 0) * D;
        const float* modL = X.mod() + (size_t)layer * 9 * 9216;
        PH(1) phase_lnmod(X0, layer, sub, do_ln, pG, pB);
        GSYNC();
        if (sub != 1) {
            const int li = layer * 2 + (sub >> 1);
            PH(2) {
                pg8::Gemm g{X.h(), X.wfi() + (size_t)li * NFI * D, MTOT, NFI, D}; pg8::StaticOrder S; S.init(MTOT, NFI, G, bid);
                EpiSwiGLU E{X.act()};
                pg8::gemm_phase<EpiSwiGLU, pg8::StaticOrder>(lds, g, S, E, nullptr);
            }
            GSYNC();
            PH(3) {
                pg8::Gemm g{X.act(), X.wfo() + (size_t)li * D * DFF, MTOT, D, DFF}; pg8::StaticOrder S; S.init(MTOT, D, G, bid);
                EpiResT<1> E{X.v(), X.stats(), pG, pB, modL, sub * 3 + 2, 0.5f, do_ln};
                pg8::gemm_phase<EpiResT<1>, pg8::StaticOrder>(lds, g, S, E, nullptr);
            }
            GSYNC();
#ifdef PROBE_FFNOUT
            { const u32x4* src = (const u32x4*)(X.ws + WS_ACT + (size_t)MTOT * DFF * 2); u32x4* dst = (u32x4*)X.v();
              for (size_t i = (size_t)bid * 512 + otid(); i < (size_t)MTOT * D / 8; i += (size_t)G * 512) dst[i] = src[i]; }
            GSYNC();
#endif
        } else {
            PH(4) {
                pg8::Gemm g{X.h(), X.wmi() + (size_t)layer * NMI * D, MTOT, NMI, D}; pg8::StaticOrder S; S.init(MTOT, NMI, G, bid);
                EpiMixIn E{X.z(), X.ptl(), X.ptc()};
                pg8::gemm_phase<EpiMixIn, pg8::StaticOrder>(lds, g, S, E, nullptr);
            }
            GSYNC();
            {
                const int nd = G >> 1, ns = G - nd;
                if (bid < nd) { PH(5) {
#pragma nounroll
                    for (int pass = 0; pass < 2; ++pass) {
                        pg8::Gemm g; pg8::StaticOrder S; EpiDft E;
                        if (pass == 0) { g = pg8::Gemm{X.dl(), X.ptl(), 4096, 2048, 8192}; S.init(4096, 2048, nd, bid); E = EpiDft{X.ycat(), MCTX, 4096}; }
                        else { g = pg8::Gemm{X.dc(), X.ptc(), 256, 4096, 512}; S.init(256, 4096, nd, bid); E = EpiDft{X.ycat(), 0, 256}; }
                        pg8::gemm_phase<EpiDft, pg8::StaticOrder>(lds, g, S, E, nullptr);
                    }
                } } else {
                    const int c = bid - nd, wave = otid() >> 6;
                    LAS unsigned char* hl = lds + wave * 5632;
                    PH(6) if (wave < 2) {
                        for (int u = c * 2 + wave; u < 256; u += ns * 2) { const int ph = u & 1, g = (u >> 1) & 15, dir = (u >> 5) & 1, bp = u >> 6;
                            s5_unit(X0, hl, layer, dir, g, ph, MCTX + bp * 4096, MCTX + (bp + 4) * 4096, 4096, bp, bp + 4, true); }
                    } else if (wave < 4) {
                        for (int u = c * 2 + (wave - 2); u < 512; u += ns * 2) { const int ph = u & 1, g = (u >> 1) & 15, dir = (u >> 5) & 1, bp = u >> 6;
                            s5_unit(X0, hl, layer, dir, g, ph, bp * 256, (bp + 8) * 256, 256, bp, bp + 8, false); }
                    } else {
                        const int slot = (wave >= 6) ? (c * 2 + (wave - 6)) : (ns * 2 + c * 2 + (wave - 4));
                        for (int ch = slot; ch < MTOT / 128; ch += ns * 4) sgu_chunk_wave(X0, layer, ch);
                    }
                }
            }
            GSYNC();
            PH(7) phase_l7(X0, layer);
            GSYNC();
            PH(8) {
                pg8::Gemm g{X.ya(), X.wglu() + (size_t)layer * 65536, MTOT, 256, 256 + (G >> 20)}; pg8::StaticOrder S; S.init(MTOT, 256, G, bid);
                EpiGlu E{X.ya(), X.ycat(), X.in[22] + layer * 256};
                pg8::gemm_phase<EpiGlu, pg8::StaticOrder>(lds, g, S, E, nullptr);
            }
            GSYNC();
            PH(9) phase_finalize(X0, layer);
            GSYNC();
            PH(10) {
                pg8::Gemm g{X.h(), X.wmo() + (size_t)layer * D * D, MTOT, D, D}; pg8::StaticOrder S; S.init(MTOT, D, G, bid);
                EpiResT<0> E{X.v(), X.stats(), pG, pB, modL, 5, 1.0f, do_ln};
                pg8::gemm_phase<EpiResT<0>, pg8::StaticOrder>(lds, g, S, E, nullptr);
            }
            GSYNC();
        }
    }
#ifdef XSYNC
#pragma nounroll
    for (int q_ = 0; q_ < XSYNC; ++q_) GSYNC();
#endif
    PH(11) phase_final_ln(X0, X0.in[28] + (size_t)11 * D, X0.in[29] + (size_t)11 * D);
}

extern "C" void kernel_launch(void* const* d_in, const int* in_sizes, int n_in, void* d_out, int out_size,
                              void* d_ws, size_t ws_size, hipStream_t stream) {
    static int grid_blocks = 0;
    if (!grid_blocks) {
        if (n_in != 30 || out_size != OUT_TOTAL || ws_size < WS_END) {
            fprintf(stderr, "kernel_launch: unexpected shapes: n_in %d out %d (want %d) ws %zu (need %zu)\n", n_in, out_size, OUT_TOTAL, ws_size, (size_t)WS_END);
            grid_blocks = -1; return;
        }
        int dev = 0, cus = 0, per_cu = 0;
        if (hipGetDevice(&dev) != hipSuccess || hipDeviceGetAttribute(&cus, hipDeviceAttributeMultiprocessorCount, dev) != hipSuccess) { grid_blocks = -1; return; }
        if (hipFuncSetAttribute((const void*)fwd_megakernel, hipFuncAttributeMaxDynamicSharedMemorySize, LDS_BYTES) != hipSuccess) { fprintf(stderr, "hipFuncSetAttribute failed\n"); grid_blocks = -1; return; }
        if (hipOccupancyMaxActiveBlocksPerMultiprocessor(&per_cu, (const void*)fwd_megakernel, 512, LDS_BYTES) != hipSuccess || per_cu < 1) {
            fprintf(stderr, "kernel_launch: occupancy query says %d blocks per CU\n", per_cu); (void)hipGetLastError(); }
        grid_blocks = cus;
    }
    if (grid_blocks < 0) return;
    Args a{};
    for (int i = 0; i < 30; ++i) a.in[i] = (const float*)d_in[i];
    a.out = (float*)d_out; a.ws = (unsigned char*)d_ws;
    void* args[] = {&a};
    hipError_t e = hipLaunchCooperativeKernel((void*)fwd_megakernel, dim3(grid_blocks), dim3(512), args, LDS_BYTES, stream);
    if (e != hipSuccess) fprintf(stderr, "cooperative launch failed: %s (grid %d)\n", hipGetErrorString(e), grid_blocks);
}
```
